# Optimizing an MI355X kernel written in HIP

```python
import math
import jax, jax.numpy as jnp
from jax import lax
import numpy as np

D_MODEL = 1024
BATCH = 8
SEQ = 4096
DEPTH = 1
DEC_BATCH = 16
DEC_SEQ = 4096
PAST_LEN = 128

MIX_WIDTH = D_MODEL
LRU_WIDTH = MIX_WIDTH // 2
POOL_WIDTH = MIX_WIDTH - LRU_WIDTH
LRU_HEADS = 8
LRU_HEAD_DIM = LRU_WIDTH // LRU_HEADS
CONV_WIDTH = 4
LRU_C = 8.0
POOL_WINDOWS = (2, 4, 8, 16)
POOL_GROUPS = len(POOL_WINDOWS)
POOL_GROUP_DIM = POOL_WIDTH // POOL_GROUPS
IN_WIDTH = 2 * LRU_WIDTH + POOL_WIDTH
D_FF = 2816
FFN_RES = 0.5
EPS = 1e-6

kernel_name = "hybrid_rglru_pool_macaron_encoder"


def rmsnorm(x, g):
    xf = x.astype(jnp.float32)
    ms = jnp.mean(xf * xf, axis=-1, keepdims=True)
    return (xf * lax.rsqrt(ms + EPS)).astype(x.dtype) * g


def swiglu(h, w_in, w_out):
    gu = h @ w_in
    g, u = jnp.split(gu, 2, axis=-1)
    return (jax.nn.silu(g) * u) @ w_out


def macaron_ffn(x, pre_g, post_g, w_in, w_out):
    y = swiglu(rmsnorm(x, pre_g), w_in, w_out)
    return x + FFN_RES * rmsnorm(y, post_g)


def centred_depthwise_conv(x, w, b):
    S = x.shape[1]
    left = CONV_WIDTH // 2
    xp = jnp.pad(x, ((0, 0), (left, CONV_WIDTH - 1 - left), (0, 0)))
    out = b.astype(jnp.float32)
    for k in range(CONV_WIDTH):
        out = out + xp[:, k:k + S, :] * w[k].astype(jnp.float32)
    return out


def _lin_combine(e1, e2):
    a1, b1 = e1
    a2, b2 = e2
    return a1 * a2, a2 * b1 + b2


def rglru_direction(xc, w_a, b_a, w_x, b_x, lam, reverse):
    B, S, R = xc.shape
    xh = xc.reshape(B, S, LRU_HEADS, LRU_HEAD_DIM)
    r = jax.nn.sigmoid(jnp.einsum('bshi,hij->bshj', xh, w_a.astype(jnp.float32)).reshape(B, S, R)
                       + b_a.astype(jnp.float32))
    i = jax.nn.sigmoid(jnp.einsum('bshi,hij->bshj', xh, w_x.astype(jnp.float32)).reshape(B, S, R)
                       + b_x.astype(jnp.float32))
    log_a = -LRU_C * r * jax.nn.softplus(-lam.astype(jnp.float32))
    a = jnp.exp(log_a)
    u = jnp.sqrt(-jnp.expm1(2.0 * log_a)) * (i * xc)
    _, h = lax.associative_scan(_lin_combine, (a, u), reverse=reverse, axis=1)
    return h


def pool_mixer(p, w_pool, scale):
    B, S, _ = p.shape
    pf = p.astype(jnp.float32)
    cs = jnp.concatenate([jnp.zeros((B, 1, POOL_WIDTH), jnp.float32), jnp.cumsum(pf, axis=1)], axis=1)
    t = jnp.arange(S)
    outs = []
    for g, w in enumerate(POOL_WINDOWS):
        sl = slice(g * POOL_GROUP_DIM, (g + 1) * POOL_GROUP_DIM)
        lo = jnp.clip(t - w // 2, 0, S)
        hi = jnp.clip(t + w // 2, 0, S)
        csg = cs[..., sl]
        cnt = (hi - lo).astype(jnp.float32)[None, :, None]
        mean = (jnp.take(csg, hi, axis=1) - jnp.take(csg, lo, axis=1)) / cnt
        d = (mean - pf[..., sl]).astype(p.dtype)
        outs.append(d @ w_pool[g])
    return jnp.concatenate(outs, axis=-1) * scale


def token_mixing(x, pre_g, post_g, w_in, conv_w, conv_b, lru_w_a, lru_b_a, lru_w_x, lru_b_x,
                 lru_lam, lru_out_g, pool_w, pool_scale, pool_out_g, w_out):
    h = rmsnorm(x, pre_g)
    z = h @ w_in
    xb = z[..., :LRU_WIDTH]
    gb = z[..., LRU_WIDTH:2 * LRU_WIDTH]
    pb = z[..., 2 * LRU_WIDTH:]
    xc = centred_depthwise_conv(xb.astype(jnp.float32), conv_w, conv_b)
    h_f = rglru_direction(xc, lru_w_a[0], lru_b_a[0], lru_w_x[0], lru_b_x[0], lru_lam[0], False)
    h_b = rglru_direction(xc, lru_w_a[1], lru_b_a[1], lru_w_x[1], lru_b_x[1], lru_lam[1], True)
    lru = (h_f + h_b).astype(x.dtype) * jax.nn.gelu(gb)
    lru = rmsnorm(lru, lru_out_g)
    pool = rmsnorm(pool_mixer(pb, pool_w, pool_scale), pool_out_g)
    o = jnp.concatenate([lru, pool], axis=-1) @ w_out
    return x + rmsnorm(o, post_g)


def encoder_layer(x, l, ffn1_pre_g, ffn1_post_g, ffn1_w_in, ffn1_w_out,
                  mix_pre_g, mix_post_g, w_in, conv_w, conv_b, lru_w_a, lru_b_a, lru_w_x, lru_b_x,
                  lru_lam, lru_out_g, pool_w, pool_scale, pool_out_g, w_out,
                  ffn2_pre_g, ffn2_post_g, ffn2_w_in, ffn2_w_out):
    x = macaron_ffn(x, ffn1_pre_g[l], ffn1_post_g[l], ffn1_w_in[l], ffn1_w_out[l])
    x = token_mixing(x, mix_pre_g[l], mix_post_g[l], w_in[l], conv_w[l], conv_b[l],
                     lru_w_a[l], lru_b_a[l], lru_w_x[l], lru_b_x[l], lru_lam[l], lru_out_g[l],
                     pool_w[l], pool_scale[l], pool_out_g[l], w_out[l])
    x = macaron_ffn(x, ffn2_pre_g[l], ffn2_post_g[l], ffn2_w_in[l], ffn2_w_out[l])
    return x


def setup_inputs(seed: int = 0) -> dict:
    key = jax.random.key(seed)
    ks = jax.random.split(key, 32)
    f32 = jnp.float32
    nrm = lambda k, shape, fan_in: jax.random.normal(k, shape, f32) * (fan_in ** -0.5)
    gain = lambda k, n: 1.0 + 0.05 * jax.random.normal(k, (DEPTH, n), f32)
    a_c = jax.random.uniform(ks[12], (DEPTH, 2, LRU_WIDTH), f32, 0.9, 0.999)
    p0 = a_c ** (1.0 / LRU_C)
    lam = jnp.log(p0) - jnp.log1p(-p0)
    return {
        "x_prompt": jax.random.normal(ks[0], (BATCH, SEQ, D_MODEL), f32),
        "x_sample": jax.random.normal(ks[1], (DEC_BATCH, DEC_SEQ, D_MODEL), f32),
        "ffn1_pre_g": gain(ks[2], D_MODEL),
        "ffn1_post_g": gain(ks[3], D_MODEL),
        "ffn1_w_in": nrm(ks[4], (DEPTH, D_MODEL, 2 * D_FF), D_MODEL),
        "ffn1_w_out": nrm(ks[5], (DEPTH, D_FF, D_MODEL), D_FF),
        "mix_pre_g": gain(ks[6], D_MODEL),
        "mix_post_g": gain(ks[7], D_MODEL),
        "w_in": nrm(ks[8], (DEPTH, D_MODEL, IN_WIDTH), D_MODEL),
        "conv_w": nrm(ks[9], (DEPTH, CONV_WIDTH, LRU_WIDTH), CONV_WIDTH),
        "conv_b": 0.02 * jax.random.normal(ks[10], (DEPTH, LRU_WIDTH), f32),
        "lru_w_a": nrm(ks[11], (DEPTH, 2, LRU_HEADS, LRU_HEAD_DIM, LRU_HEAD_DIM), LRU_HEAD_DIM),
        "lru_b_a": 0.02 * jax.random.normal(ks[13], (DEPTH, 2, LRU_WIDTH), f32),
        "lru_w_x": nrm(ks[14], (DEPTH, 2, LRU_HEADS, LRU_HEAD_DIM, LRU_HEAD_DIM), LRU_HEAD_DIM),
        "lru_b_x": 0.02 * jax.random.normal(ks[15], (DEPTH, 2, LRU_WIDTH), f32),
        "lru_lam": lam,
        "lru_out_g": gain(ks[16], LRU_WIDTH),
        "pool_w": nrm(ks[17], (DEPTH, POOL_GROUPS, POOL_GROUP_DIM, POOL_GROUP_DIM), POOL_GROUP_DIM),
        "pool_scale": 1.0 + 0.1 * jax.random.normal(ks[18], (DEPTH, POOL_WIDTH), f32),
        "pool_out_g": gain(ks[19], POOL_WIDTH),
        "w_out": nrm(ks[20], (DEPTH, MIX_WIDTH, D_MODEL), MIX_WIDTH),
        "ffn2_pre_g": gain(ks[21], D_MODEL),
        "ffn2_post_g": gain(ks[22], D_MODEL),
        "ffn2_w_in": nrm(ks[23], (DEPTH, D_MODEL, 2 * D_FF), D_MODEL),
        "ffn2_w_out": nrm(ks[24], (DEPTH, D_FF, D_MODEL), D_FF),
    }


def reference(x_prompt, x_sample, ffn1_pre_g, ffn1_post_g, ffn1_w_in, ffn1_w_out,
              mix_pre_g, mix_post_g, w_in, conv_w, conv_b, lru_w_a, lru_b_a, lru_w_x, lru_b_x,
              lru_lam, lru_out_g, pool_w, pool_scale, pool_out_g, w_out,
              ffn2_pre_g, ffn2_post_g, ffn2_w_in, ffn2_w_out):
    y_prompt = x_prompt
    y_sample = x_sample
    for l in range(DEPTH):
        y_prompt = encoder_layer(y_prompt, l, ffn1_pre_g, ffn1_post_g, ffn1_w_in, ffn1_w_out,
                                 mix_pre_g, mix_post_g, w_in, conv_w, conv_b, lru_w_a, lru_b_a,
                                 lru_w_x, lru_b_x, lru_lam, lru_out_g, pool_w, pool_scale,
                                 pool_out_g, w_out, ffn2_pre_g, ffn2_post_g, ffn2_w_in, ffn2_w_out)
        y_sample = encoder_layer(y_sample, l, ffn1_pre_g, ffn1_post_g, ffn1_w_in, ffn1_w_out,
                                 mix_pre_g, mix_post_g, w_in, conv_w, conv_b, lru_w_a, lru_b_a,
                                 lru_w_x, lru_b_x, lru_lam, lru_out_g, pool_w, pool_scale,
                                 pool_out_g, w_out, ffn2_pre_g, ffn2_post_g, ffn2_w_in, ffn2_w_out)
    return (y_prompt, y_sample)
```

```cpp
#include <hip/hip_runtime.h>
#include <hip/hip_cooperative_groups.h>
#include <cstdio>
namespace cg = cooperative_groups;

#ifndef MK_COOP
#define MK_COOP 1
#endif
#ifndef MK_MASK
#define MK_MASK 0xff
#endif

#define LAS __attribute__((address_space(3)))
typedef unsigned short bf16_t;
typedef short bf16x8 __attribute__((ext_vector_type(8)));
typedef float f32x4 __attribute__((ext_vector_type(4)));
typedef float f32x2 __attribute__((ext_vector_type(2)));
typedef unsigned u32x4 __attribute__((ext_vector_type(4)));
typedef unsigned u32x2 __attribute__((ext_vector_type(2)));

constexpr int T_ROWS = 98304, TP_ROWS = 32768, SEQ = 4096, NSEQ = 24, DM = 1024, DFF = 2816, INW = 1536, LRW = 512;
constexpr int NCHUNK = 64;
constexpr float EPS = 1e-6f;
constexpr int LDS_ROW = 516;
constexpr int LDS_BYTES = 64 * LDS_ROW * 4;

constexpr size_t SZ_W1 = (size_t)2 * DFF * DM * 2, SZ_W2 = (size_t)DM * DFF * 2, SZ_W3 = (size_t)INW * DM * 2, SZ_W4 = (size_t)DM * DM * 2;
constexpr size_t WS_W1 = 0, WS_W2 = WS_W1 + SZ_W1, WS_W3 = WS_W2 + SZ_W2, WS_W4 = WS_W3 + SZ_W3, WS_W5 = WS_W4 + SZ_W4, WS_W6 = WS_W5 + SZ_W1;
constexpr size_t WS_WG = WS_W6 + SZ_W2;
constexpr size_t WS_WP = WS_WG + (size_t)2 * 2 * 8 * 64 * 64 * 2;
constexpr size_t WS_C8 = WS_WP + (size_t)4 * 128 * 128 * 2;
constexpr size_t WS_XN = WS_C8 + 4096;
constexpr size_t WS_XR = WS_XN + (size_t)T_ROWS * DM * 2;
constexpr size_t WS_H = WS_XR + (size_t)T_ROWS * DM * 2;
constexpr size_t WS_Z = WS_H;
constexpr size_t WS_AGG = WS_Z + (size_t)T_ROWS * INW * 2;
constexpr size_t WS_CAR = WS_AGG + (size_t)2 * NSEQ * NCHUNK * LRW * 8;
constexpr size_t WS_XA = WS_CAR + (size_t)2 * NSEQ * NCHUNK * LRW * 4;
constexpr size_t WS_END = WS_H + (size_t)T_ROWS * DFF * 2;
constexpr size_t WS_BAR = WS_END;
constexpr size_t WS_TOTAL = WS_BAR + 16384;
constexpr int LDS_TOTAL = LDS_BYTES + 16;
static_assert(WS_XA + (size_t)NSEQ * NCHUNK * 8 * 8 * 64 * 16 <= WS_END, "mixer scratch must fit inside the H region");

struct Params {
    const float *xp, *xs;
    const float *f1_pre, *f1_post, *f1_win, *f1_wout;
    const float *mx_pre, *mx_post, *w_in, *conv_w, *conv_b, *w_a, *b_a, *w_x, *b_x, *lam, *lru_g, *pool_w, *pool_scale, *pool_g, *w_out;
    const float *f2_pre, *f2_post, *f2_win, *f2_wout;
    float* out;
    bf16_t *W1, *W2, *W3, *W4, *W5, *W6, *WG, *WP, *XN, *XR, *O, *H, *Z;
    f32x2* AGG; float* CAR; float* C8; unsigned* BAR; u32x4* XA;
};

__device__ __forceinline__ unsigned pk2(float lo, float hi) { unsigned r; asm volatile("v_cvt_pk_bf16_f32 %0, %1, %2" : "=v"(r) : "v"(lo), "v"(hi)); return r; }
__device__ __forceinline__ float bflo(unsigned v) { return __uint_as_float(v << 16); }
__device__ __forceinline__ float bfhi(unsigned v) { return __uint_as_float(v & 0xffff0000u); }
__device__ __forceinline__ float wave_sum(float v) {
#pragma unroll
    for (int o = 1; o < 64; o <<= 1) v += __shfl_xor(v, o);
    return v;
}
__device__ __forceinline__ float fsigmoid(float x) { return __builtin_amdgcn_rcpf(1.0f + __builtin_amdgcn_exp2f(-1.4426950408889634f * x)); }
__device__ __forceinline__ float fsilu(float x) { return x * fsigmoid(x); }
__device__ __forceinline__ float fgelu_tanh(float x) { const float y = 0.7978845608028654f * (x + 0.044715f * x * x * x); return x * fsigmoid(2.0f * y); }
__device__ __forceinline__ int opaque_tid() { int t = threadIdx.x; asm volatile("" : "+v"(t)); return t; }
__device__ __forceinline__ f32x2 rcp2(f32x2 v) { return (f32x2){__builtin_amdgcn_rcpf(v.x), __builtin_amdgcn_rcpf(v.y)}; }
__device__ __forceinline__ f32x2 exp2_2(f32x2 v) { return (f32x2){__builtin_amdgcn_exp2f(v.x), __builtin_amdgcn_exp2f(v.y)}; }
__device__ __forceinline__ f32x2 silu_mul2(f32x2 g, f32x2 u) { return (g * u) * rcp2(exp2_2(g * (-1.4426950408889634f)) + 1.0f); }
__device__ __forceinline__ f32x2 gelu_mul2(f32x2 x, f32x2 s) {
    const f32x2 t = (x * x) * 0.044715f + 1.0f, arg = (x * t) * (-2.0f * 0.7978845608028654f * 1.4426950408889634f);
    return (s * x) * rcp2(exp2_2(arg) + 1.0f); }
__device__ __forceinline__ f32x2 bf2(unsigned v) { return (f32x2){__uint_as_float(v << 16), __uint_as_float(v & 0xffff0000u)}; }
__device__ __forceinline__ void lds_barrier() { asm volatile("s_waitcnt lgkmcnt(0)\n\ts_barrier" ::: "memory"); }
#define LDS_WAIT() asm volatile("s_waitcnt lgkmcnt(0)" ::: "memory")

namespace pg8 {
constexpr int BM = 256, BK = 64, HALF = 128, HTB = HALF * BK * 2, STAGE_BYTES = 8 * HTB, NXCD = 8, WGM = 8;
__host__ __device__ __forceinline__ int lds_byte(int r, int c) { const int st = (r >> 4) * 2 + (c >> 5), rr = r & 15, cc = c & 31, ob = rr * 64 + cc * 2; return st * 1024 + (ob ^ (((ob >> 9) & 1) << 5)); }
__host__ __device__ __forceinline__ void stage_rc(int b, int& R, int& C) { const int st = b / 1024, sb = b % 1024, swz = sb ^ (((sb >> 9) & 1) << 5); R = (st >> 1) * 16 + swz / 64; C = (st & 1) * 32 + (swz % 64) / 2; }
__host__ __device__ __forceinline__ int perm32(int rho) { const int n = rho >> 4, i = rho & 15; return 8 * (i >> 2) + 4 * n + (i & 3); }
struct Unit { int pm, pn; };
struct Gemm { const bf16_t* A; const bf16_t* Bt; int M, N, K; };
struct StaticOrder {
    int nM, nN, nwg, G, c;
    __host__ __device__ void init(int M, int N, int G_, int c_) { nM = M / BM; nN = N / BM; nwg = nM * nN; G = G_; c = c_; }
    __host__ __device__ bool next(int i, Unit& u) const {
        const long L = (long)i * G + c; if (L >= nwg) return false;
        int wgid = (int)L; { const int q = nwg / NXCD, r = nwg % NXCD, xcd = wgid % NXCD, off = wgid / NXCD; wgid = (xcd < r ? xcd * (q + 1) : r * (q + 1) + (xcd - r) * q) + off; }
        const int nig = WGM * nN, gid = wgid / nig, fm = gid * WGM, gsz = (nM - fm) < WGM ? (nM - fm) : WGM;
        u.pm = fm + ((wgid % nig) % gsz); u.pn = (wgid % nig) / gsz; return true;
    }
    __device__ __forceinline__ void a_ready(const Unit&) const {}
    __device__ __forceinline__ void done(const Unit&) const {}
};

struct EpiBf16 {
    static constexpr bool PERM = true;
    bf16_t* O; int ldc;
    __device__ __forceinline__ void operator()(const f32x4 (&acc)[2][2][4][2], const Unit& u, int wr, int wc, int fr, int fq) const {
        const int row0 = u.pm * BM + wr * 64 + fr, col0 = u.pn * BM + wc * 32 + 8 * fq;
#pragma unroll
        for (int ai = 0; ai < 2; ++ai)
#pragma unroll
            for (int m = 0; m < 4; ++m) { bf16_t* rowp = O + (size_t)(row0 + ai * HALF + m * 16) * ldc + col0;
#pragma unroll
                for (int bj = 0; bj < 2; ++bj) { const f32x4 v0 = acc[ai][bj][m][0], v1 = acc[ai][bj][m][1];
                    u32x4 w; w.x = pk2(v0[0], v0[1]); w.y = pk2(v0[2], v0[3]); w.z = pk2(v1[0], v1[1]); w.w = pk2(v1[2], v1[3]);
                    *(u32x4*)(rowp + bj * HALF) = w; } }
    }
};
struct EpiSwiGLU {
    static constexpr bool PERM = true;
    bf16_t* O;
    __device__ __forceinline__ void operator()(const f32x4 (&acc)[2][2][4][2], const Unit& u, int wr, int wc, int fr, int fq) const {
        const int row0 = u.pm * BM + wr * 64 + fr, col0 = u.pn * HALF + wc * 32 + 8 * fq;
#pragma unroll
        for (int ai = 0; ai < 2; ++ai)
#pragma unroll
            for (int m = 0; m < 4; ++m) { bf16_t* rowp = O + (size_t)(row0 + ai * HALF + m * 16) * DFF + col0;
                const f32x4 g0 = acc[ai][0][m][0], g1 = acc[ai][0][m][1], u0 = acc[ai][1][m][0], u1 = acc[ai][1][m][1];
                const f32x2 h0 = silu_mul2((f32x2){g0[0], g0[1]}, (f32x2){u0[0], u0[1]}), h1 = silu_mul2((f32x2){g0[2], g0[3]}, (f32x2){u0[2], u0[3]});
                const f32x2 h2 = silu_mul2((f32x2){g1[0], g1[1]}, (f32x2){u1[0], u1[1]}), h3 = silu_mul2((f32x2){g1[2], g1[3]}, (f32x2){u1[2], u1[3]});
                u32x4 w; w.x = pk2(h0.x, h0.y); w.y = pk2(h1.x, h1.y); w.z = pk2(h2.x, h2.y); w.w = pk2(h3.x, h3.y);
                __builtin_nontemporal_store(w, (u32x4*)rowp); }
    }
};

template <class Epi, class Sched>
__device__ __forceinline__ void gemm_phase(LAS unsigned char* lds, const Gemm g, const Sched& S, const Epi& E) {
    const int tid = opaque_tid(), wid = __builtin_amdgcn_readfirstlane(tid >> 6), lane = tid & 63, wr = wid >> 2, wc = wid & 3, fr = lane & 15, fq = lane >> 4;
    const int K = g.K, nt = K / BK;
    unsigned voffA[2], voffB[2];
#pragma unroll
    for (int i = 0; i < 2; ++i) { int R, C; stage_rc(tid * 16 + i * 8192, R, C); const int Rb = Epi::PERM ? ((R & ~31) + perm32(R & 31)) : R;
        voffA[i] = (unsigned)(R * K + C) * 2u; voffB[i] = (unsigned)(Rb * K + C) * 2u; }
    const size_t kstep = (size_t)(BK * 2);
    const size_t hstep = (size_t)HALF * K * 2;
    const size_t tstep = 2 * hstep;
    const unsigned ldsw = (unsigned)wid * 1024u;
    const int aoff = lds_byte(wr * 64 + fr, fq * 8), boff = lds_byte(wc * 32 + fr, fq * 8);
#define PG8_SA(b, h) (((b) * 2 + (h)) * HTB)
#define PG8_SB(b, h) ((4 + (b) * 2 + (h)) * HTB)
#define PG8_STAGE(bufoff, gbase, voff) do { _Pragma("unroll") for (int _i = 0; _i < 2; ++_i) \
        __builtin_amdgcn_global_load_lds((const unsigned*)((const char*)(gbase) + (voff)[_i]), (LAS unsigned*)(lds + (bufoff) + ldsw + _i * 8192), 16, 0, 0); } while (0)
#define PG8_LDA(dst, b, h) do { _Pragma("unroll") for (int m = 0; m < 4; ++m) _Pragma("unroll") for (int k = 0; k < 2; ++k) dst[m][k] = *(const LAS bf16x8*)(lds + PG8_SA(b, h) + aoff + m * 2048 + k * 1024); } while (0)
#define PG8_LDB(dst, b, h) do { _Pragma("unroll") for (int n = 0; n < 2; ++n) _Pragma("unroll") for (int k = 0; k < 2; ++k) dst[n][k] = *(const LAS bf16x8*)(lds + PG8_SB(b, h) + boff + n * 2048 + k * 1024); } while (0)
#define PG8_MMA(ai, bj, At, Bt) do { __builtin_amdgcn_s_setprio(1); _Pragma("unroll") for (int m = 0; m < 4; ++m) _Pragma("unroll") for (int n = 0; n < 2; ++n) _Pragma("unroll") for (int k = 0; k < 2; ++k) \
        acc[ai][bj][m][n] = __builtin_amdgcn_mfma_f32_16x16x32_bf16(Bt[n][k], At[m][k], acc[ai][bj][m][n], 0, 0, 0); __builtin_amdgcn_s_setprio(0); } while (0)
#define PG8_WAIT_V(n) asm volatile("s_waitcnt vmcnt(" #n ")" ::: "memory")
#define PG8_WAIT_L(n) asm volatile("s_waitcnt lgkmcnt(" #n ")" ::: "memory")
#define PG8_BAR __builtin_amdgcn_s_barrier()
#define PG8_SCHED __builtin_amdgcn_sched_barrier(0)
    Unit cur, nxt; int ui = 0;
    if (!S.next(0, cur)) return;
    f32x4 acc[2][2][4][2];
#pragma unroll
    for (int a = 0; a < 2; ++a)
#pragma unroll
        for (int b = 0; b < 2; ++b)
#pragma unroll
            for (int m = 0; m < 4; ++m)
#pragma unroll
                for (int n = 0; n < 2; ++n) acc[a][b][m][n] = (f32x4){0.f, 0.f, 0.f, 0.f};
    bf16x8 At[4][2], B0[2][2], B1[2][2];
    const char* cA = (const char*)g.A + (size_t)cur.pm * tstep; const char* cB = (const char*)g.Bt + (size_t)cur.pn * tstep;
    S.a_ready(cur);
    PG8_STAGE(PG8_SB(0, 0), cB, voffB); PG8_STAGE(PG8_SA(0, 0), cA, voffA); PG8_STAGE(PG8_SB(0, 1), cB + hstep, voffB); PG8_STAGE(PG8_SA(0, 1), cA + hstep, voffA);
    if (wr == 1) PG8_BAR;
    PG8_WAIT_V(4); PG8_BAR;
    PG8_STAGE(PG8_SB(1, 0), cB + kstep, voffB); PG8_STAGE(PG8_SA(1, 0), cA + kstep, voffA); PG8_STAGE(PG8_SB(1, 1), cB + hstep + kstep, voffB);
    PG8_WAIT_V(6); PG8_BAR;
    for (;;) {
        const bool has_next = S.next(ui + 1, nxt);
        const char* nA = has_next ? (const char*)g.A + (size_t)nxt.pm * tstep : cA; const char* nB = has_next ? (const char*)g.Bt + (size_t)nxt.pn * tstep : cB;
        for (int t = 0; t < nt; t += 2) {
            const bool last = (t == nt - 2);
            const char* a1 = cA + (size_t)(t + 1) * kstep;
            const char* a2 = last ? nA : cA + (size_t)(t + 2) * kstep; const char* b2 = last ? nB : cB + (size_t)(t + 2) * kstep;
            const char* a3 = a2 + kstep; const char* b3 = b2 + kstep;
            if (last && has_next) S.a_ready(nxt);
            PG8_LDB(B0, 0, 0); PG8_SCHED; PG8_LDA(At, 0, 0); PG8_STAGE(PG8_SA(1, 1), a1 + hstep, voffA);
            PG8_WAIT_L(8); PG8_BAR; PG8_WAIT_L(0); PG8_MMA(0, 0, At, B0); PG8_BAR; PG8_SCHED;
            PG8_LDB(B1, 0, 1); PG8_STAGE(PG8_SB(0, 0), b2, voffB);
            PG8_BAR; PG8_WAIT_L(0); PG8_MMA(0, 1, At, B1); PG8_BAR;
            PG8_LDA(At, 0, 1); PG8_STAGE(PG8_SA(0, 0), a2, voffA);
            PG8_BAR; PG8_WAIT_L(0); PG8_MMA(1, 0, At, B0); PG8_BAR; PG8_SCHED;
            PG8_STAGE(PG8_SB(0, 1), b2 + hstep, voffB);
            PG8_WAIT_V(6); PG8_BAR; PG8_MMA(1, 1, At, B1); PG8_BAR;
            PG8_LDB(B0, 1, 0); PG8_SCHED; PG8_LDA(At, 1, 0); PG8_STAGE(PG8_SA(0, 1), a2 + hstep, voffA);
            PG8_WAIT_L(8); PG8_BAR; PG8_WAIT_L(0); PG8_MMA(0, 0, At, B0); PG8_BAR; PG8_SCHED;
            PG8_LDB(B1, 1, 1); PG8_STAGE(PG8_SB(1, 0), b3, voffB);
            PG8_BAR; PG8_WAIT_L(0); PG8_MMA(0, 1, At, B1); PG8_BAR;
            PG8_LDA(At, 1, 1); PG8_STAGE(PG8_SA(1, 0), a3, voffA);
            PG8_BAR; PG8_WAIT_L(0); PG8_MMA(1, 0, At, B0); PG8_BAR; PG8_SCHED;
            PG8_STAGE(PG8_SB(1, 1), b3 + hstep, voffB);
            PG8_WAIT_V(6); PG8_BAR; PG8_MMA(1, 1, At, B1); PG8_BAR;
        }
        E(acc, cur, wr, wc, fr, fq); S.done(cur);
        if (!has_next) break;
#pragma unroll
        for (int a = 0; a < 2; ++a)
#pragma unroll
            for (int b = 0; b < 2; ++b)
#pragma unroll
                for (int m = 0; m < 4; ++m)
#pragma unroll
                    for (int n = 0; n < 2; ++n) acc[a][b][m][n] = (f32x4){0.f, 0.f, 0.f, 0.f};
        cur = nxt; cA = nA; cB = nB; ++ui;
    }
    PG8_WAIT_V(0);
    if (wr == 0) PG8_BAR;
    PG8_BAR;
#undef PG8_SA
#undef PG8_SB
#undef PG8_STAGE
#undef PG8_LDA
#undef PG8_LDB
#undef PG8_MMA
#undef PG8_WAIT_V
#undef PG8_WAIT_L
#undef PG8_BAR
#undef PG8_SCHED
}
}

__device__ __forceinline__ void tr_item(const float* W, int ldw, int k0, int n0, bf16_t* WT, int ldt, int drow0, LAS float* scr, int lane) {
#pragma unroll 8
    for (int i = 0; i < 32; ++i) { const int kk = 2 * i + (lane >> 5); scr[kk * 33 + (lane & 31)] = W[(size_t)(k0 + kk) * ldw + n0 + (lane & 31)]; }
    LDS_WAIT();
    const int c = lane & 7;
#pragma unroll
    for (int j = 0; j < 4; ++j) { const int n = (lane >> 3) + 8 * j; const LAS float* s = scr + (8 * c) * 33 + n;
        u32x4 o; o.x = pk2(s[0 * 33], s[1 * 33]); o.y = pk2(s[2 * 33], s[3 * 33]); o.z = pk2(s[4 * 33], s[5 * 33]); o.w = pk2(s[6 * 33], s[7 * 33]);
        *(u32x4*)(WT + (size_t)(drow0 + n) * ldt + k0 + 8 * c) = o; }
    LDS_WAIT();
}
__device__ __forceinline__ int swiglu_row(int n0) {
    return n0 < DFF ? 256 * (n0 / 128) + (n0 % 128) : 256 * ((n0 - DFF) / 128) + 128 + ((n0 - DFF) % 128);
}
__device__ __forceinline__ void phase_prep(const Params& p, LAS unsigned char* lds, int wave, int lane) {
    LAS float* scr = (LAS float*)(lds + wave * 16384);
    const int gw = blockIdx.x * 8 + wave, NGW = gridDim.x * 8;
    constexpr int I_IN = (DM / 64) * (2 * DFF / 32), I_OUT = (DFF / 64) * (DM / 32), I_3 = (DM / 64) * (INW / 32), I_4 = (DM / 64) * (DM / 32), I_G = 32 * 2, I_P = 4 * 2 * 4;
    constexpr int NITEMS = 2 * I_IN + 2 * I_OUT + I_3 + I_4 + I_G + I_P;
    for (int it = gw; it < NITEMS; it += NGW) {
        int r = it;
        if (r < 2 * I_IN) { const bool second = r >= I_IN; if (second) r -= I_IN; const int nblk = 2 * DFF / 32, kb = r / nblk, nb = r % nblk;
            tr_item(second ? p.f2_win : p.f1_win, 2 * DFF, 64 * kb, 32 * nb, second ? p.W5 : p.W1, DM, swiglu_row(32 * nb), scr, lane); continue; }
        r -= 2 * I_IN;
        if (r < 2 * I_OUT) { const bool second = r >= I_OUT; if (second) r -= I_OUT; const int nblk = DM / 32, kb = r / nblk, nb = r % nblk;
            tr_item(second ? p.f2_wout : p.f1_wout, DM, 64 * kb, 32 * nb, second ? p.W6 : p.W2, DFF, 32 * nb, scr, lane); continue; }
        r -= 2 * I_OUT;
        if (r < I_3) { const int nblk = INW / 32, kb = r / nblk, nb = r % nblk; tr_item(p.w_in, INW, 64 * kb, 32 * nb, p.W3, DM, 32 * nb, scr, lane); continue; }
        r -= I_3;
        if (r < I_4) { const int nblk = DM / 32, kb = r / nblk, nb = r % nblk; tr_item(p.w_out, DM, 64 * kb, 32 * nb, p.W4, DM, 32 * nb, scr, lane); continue; }
        r -= I_4;
        if (r < I_G) { const int mat = r >> 5, mi = (r >> 1) & 15, nb = r & 1;
            tr_item((mat ? p.w_x : p.w_a) + (size_t)mi * 4096, 64, 0, 32 * nb, p.WG + (size_t)(mat * 16 + mi) * 4096, 64, 32 * nb, scr, lane); continue; }
        r -= I_G;
        { const int g = r >> 3, kb = (r >> 2) & 1, nb = r & 3; tr_item(p.pool_w + (size_t)g * 16384, 128, 64 * kb, 32 * nb, p.WP + (size_t)g * 16384, 128, 32 * nb, scr, lane); }
    }
    if (blockIdx.x == 0) { for (int i = threadIdx.x; i < 2 * LRW; i += 512) p.C8[i] = -8.0f * 1.4426950408889634f * log1pf(expf(-p.lam[i])); }
    f32x4 gv[4];
#pragma unroll
    for (int j = 0; j < 4; ++j) gv[j] = *(const f32x4*)(p.f1_pre + j * 256 + lane * 4);
    f32x4 vn[4];
#define PREP_ISSUE(r_) do { const float* xr_ = (r_) < TP_ROWS ? p.xp + (size_t)(r_) * DM : p.xs + (size_t)((r_) - TP_ROWS) * DM; \
        _Pragma("unroll") for (int j = 0; j < 4; ++j) vn[j] = *(const f32x4*)(xr_ + j * 256 + lane * 4); } while (0)
    if (gw < T_ROWS) PREP_ISSUE(gw);
    for (int r = gw; r < T_ROWS; r += NGW) {
        f32x4 v[4]; float ss = 0.f;
#pragma unroll
        for (int j = 0; j < 4; ++j) { v[j] = vn[j]; ss += (v[j][0] * v[j][0] + v[j][1] * v[j][1]) + (v[j][2] * v[j][2] + v[j][3] * v[j][3]); }
        if (r + NGW < T_ROWS) PREP_ISSUE(r + NGW);
        const float sc = rsqrtf(wave_sum(ss) * (1.0f / DM) + EPS);
        bf16_t* o = p.XN + (size_t)r * DM;
#pragma unroll
        for (int j = 0; j < 4; ++j) { u32x2 w; w.x = pk2(v[j][0] * sc * gv[j][0], v[j][1] * sc * gv[j][1]); w.y = pk2(v[j][2] * sc * gv[j][2], v[j][3] * sc * gv[j][3]); *(u32x2*)(o + j * 256 + lane * 4) = w; }
    }
}

template <int MODE>
__device__ __forceinline__ void phase_rows(const Params& p, int wave, int lane) {
    const int gw = blockIdx.x * 8 + wave, NGW = gridDim.x * 8;
    const float* gpost = MODE == 0 ? p.f1_post : (MODE == 1 ? p.mx_post : p.f2_post);
    const float* gnext = MODE == 0 ? p.mx_pre : p.f2_pre;
    const float alpha = MODE == 1 ? 1.0f : 0.5f;
    f32x4 gp[4], gn[4];
#pragma unroll
    for (int j = 0; j < 4; ++j) { gp[j] = *(const f32x4*)(gpost + j * 256 + lane * 4); if (MODE != 2) gn[j] = *(const f32x4*)(gnext + j * 256 + lane * 4); }
    f32x4 nxf[2][4]; u32x2 nxb[2][4], nyb[2][4];
#define ROWS_ISSUE(rb_) do { _Pragma("unroll") for (int q = 0; q < 2; ++q) { const int r_ = ((rb_) + q * NGW < T_ROWS) ? (rb_) + q * NGW : (rb_); \
        const bf16_t* yr_ = (MODE == 1 ? p.O : p.XN) + (size_t)r_ * DM; \
        _Pragma("unroll") for (int j = 0; j < 4; ++j) { \
            if (MODE == 0) { const float* xr_ = r_ < TP_ROWS ? p.xp + (size_t)r_ * DM : p.xs + (size_t)(r_ - TP_ROWS) * DM; nxf[q][j] = *(const f32x4*)(xr_ + j * 256 + lane * 4); } \
            else nxb[q][j] = *(const u32x2*)(p.XR + (size_t)r_ * DM + j * 256 + lane * 4); \
            nyb[q][j] = *(const u32x2*)(yr_ + j * 256 + lane * 4); } } } while (0)
    if (gw < T_ROWS) ROWS_ISSUE(gw);
    for (int rb = gw; rb < T_ROWS; rb += 2 * NGW) {
        int rr[2]; rr[0] = rb; rr[1] = rb + NGW < T_ROWS ? rb + NGW : rb;
        f32x4 x[2][4], y[2][4];
#pragma unroll
        for (int q = 0; q < 2; ++q)
#pragma unroll
            for (int j = 0; j < 4; ++j) {
                if (MODE == 0) x[q][j] = nxf[q][j]; else x[q][j] = (f32x4){bflo(nxb[q][j].x), bfhi(nxb[q][j].x), bflo(nxb[q][j].y), bfhi(nxb[q][j].y)};
                y[q][j] = (f32x4){bflo(nyb[q][j].x), bfhi(nyb[q][j].x), bflo(nyb[q][j].y), bfhi(nyb[q][j].y)};
            }
        if (rb + 2 * NGW < T_ROWS) ROWS_ISSUE(rb + 2 * NGW);
        float ss[2] = {0.f, 0.f};
#pragma unroll
        for (int q = 0; q < 2; ++q)
#pragma unroll
            for (int j = 0; j < 4; ++j) ss[q] += (y[q][j][0] * y[q][j][0] + y[q][j][1] * y[q][j][1]) + (y[q][j][2] * y[q][j][2] + y[q][j][3] * y[q][j][3]);
#pragma unroll
        for (int o = 1; o < 64; o <<= 1) { ss[0] += __shfl_xor(ss[0], o); ss[1] += __shfl_xor(ss[1], o); }
        float s2[2] = {0.f, 0.f};
#pragma unroll
        for (int q = 0; q < 2; ++q) {
            const int r = rr[q];
            const float sc = rsqrtf(ss[q] * (1.0f / DM) + EPS) * alpha;
#pragma unroll
            for (int j = 0; j < 4; ++j) {
#pragma unroll
                for (int e = 0; e < 4; ++e) x[q][j][e] += y[q][j][e] * sc * gp[j][e];
                if (MODE == 2) __builtin_nontemporal_store(x[q][j], (f32x4*)(p.out + (size_t)r * DM + j * 256 + lane * 4));
                else {
                    u32x2 w; w.x = pk2(x[q][j][0], x[q][j][1]); w.y = pk2(x[q][j][2], x[q][j][3]); __builtin_nontemporal_store(w, (u32x2*)(p.XR + (size_t)r * DM + j * 256 + lane * 4));
                    x[q][j] = (f32x4){bflo(w.x), bfhi(w.x), bflo(w.y), bfhi(w.y)};
#pragma unroll
                    for (int e = 0; e < 4; ++e) s2[q] += x[q][j][e] * x[q][j][e];
                }
            }
        }
        if (MODE != 2) {
#pragma unroll
            for (int o = 1; o < 64; o <<= 1) { s2[0] += __shfl_xor(s2[0], o); s2[1] += __shfl_xor(s2[1], o); }
#pragma unroll
            for (int q = 0; q < 2; ++q) {
                const float sn = rsqrtf(s2[q] * (1.0f / DM) + EPS);
                bf16_t* o = p.XN + (size_t)rr[q] * DM;
#pragma unroll
                for (int j = 0; j < 4; ++j) { u32x2 w; w.x = pk2(x[q][j][0] * sn * gn[j][0], x[q][j][1] * sn * gn[j][1]); w.y = pk2(x[q][j][2] * sn * gn[j][2], x[q][j][3] * sn * gn[j][3]); *(u32x2*)(o + j * 256 + lane * 4) = w; }
            }
        }
    }
}

__device__ __forceinline__ f32x4 mfma16(bf16x8 a, bf16x8 b, f32x4 c) { return __builtin_amdgcn_mfma_f32_16x16x32_bf16(a, b, c, 0, 0, 0); }

__device__ __forceinline__ void gate_prefetch(const Params& p, size_t row0, int wave, int lane, int i0, u32x4 (&gb)[4]) {
#pragma unroll
    for (int i = 0; i < 4; ++i) gb[i] = *(const u32x4*)(p.Z + (row0 + wave * 8 + i0 + i) * INW + LRW + lane * 8);
}
template <bool GATE>
__device__ __forceinline__ void finalize_rows(const Params& p, const LAS float* img, size_t row0, const float* gain, int coloff, int wave, int lane, u32x4 (&gb)[4]) {
    const int c = lane * 8;
    const f32x4 g0 = *(const f32x4*)(gain + c), g1 = *(const f32x4*)(gain + c + 4);
#pragma unroll
    for (int i0 = 0; i0 < 8; i0 += 4) {
        f32x4 s0[4], s1[4]; float ss[4];
        u32x4 gc[4];
#pragma unroll
        for (int i = 0; i < 4; ++i) gc[i] = gb[i];
        if (GATE && i0 == 0) gate_prefetch(p, row0, wave, lane, 4, gb);
#pragma unroll
        for (int i = 0; i < 4; ++i) { const int tl = wave * 8 + i0 + i; s0[i] = *(const LAS f32x4*)(img + tl * LDS_ROW + c); s1[i] = *(const LAS f32x4*)(img + tl * LDS_ROW + c + 4); }
#pragma unroll
        for (int i = 0; i < 4; ++i) {
            if (GATE) {
                const u32x4 g = gc[i];
                const f32x2 a0 = gelu_mul2(bf2(g.x), (f32x2){s0[i][0], s0[i][1]}), a1 = gelu_mul2(bf2(g.y), (f32x2){s0[i][2], s0[i][3]});
                const f32x2 a2 = gelu_mul2(bf2(g.z), (f32x2){s1[i][0], s1[i][1]}), a3 = gelu_mul2(bf2(g.w), (f32x2){s1[i][2], s1[i][3]});
                s0[i] = (f32x4){a0.x, a0.y, a1.x, a1.y}; s1[i] = (f32x4){a2.x, a2.y, a3.x, a3.y};
            }
            ss[i] = (s0[i][0] * s0[i][0] + s0[i][1] * s0[i][1]) + (s0[i][2] * s0[i][2] + s0[i][3] * s0[i][3]) + (s1[i][0] * s1[i][0] + s1[i][1] * s1[i][1]) + (s1[i][2] * s1[i][2] + s1[i][3] * s1[i][3]);
        }
#pragma unroll
        for (int o = 1; o < 64; o <<= 1) {
#pragma unroll
            for (int i = 0; i < 4; ++i) ss[i] += __shfl_xor(ss[i], o);
        }
#pragma unroll
        for (int i = 0; i < 4; ++i) {
            const float sc = rsqrtf(ss[i] * (1.0f / LRW) + EPS);
            u32x4 w; w.x = pk2(s0[i][0] * sc * g0[0], s0[i][1] * sc * g0[1]); w.y = pk2(s0[i][2] * sc * g0[2], s0[i][3] * sc * g0[3]);
            w.z = pk2(s1[i][0] * sc * g1[0], s1[i][1] * sc * g1[1]); w.w = pk2(s1[i][2] * sc * g1[2], s1[i][3] * sc * g1[3]);
            *(u32x4*)(p.XN + (row0 + wave * 8 + i0 + i) * DM + coloff + c) = w;
        }
    }
}

struct GateSet { bf16x8 Ba[2], Bx[2]; float ba, bx, c8, car; };
template <bool FINAL>
__device__ __forceinline__ void gate_load(const Params& p, GateSet& G, int head, int cb, int dir, int fr, int fq, int seq, int chunk) {
    const int chl = head * 64 + cb * 16 + fr;
    const bf16_t* wa = p.WG + (size_t)((0 * 2 + dir) * 8 + head) * 4096 + (cb * 16 + fr) * 64 + fq * 8;
    const bf16_t* wx = p.WG + (size_t)((1 * 2 + dir) * 8 + head) * 4096 + (cb * 16 + fr) * 64 + fq * 8;
    G.Ba[0] = *(const bf16x8*)wa; G.Ba[1] = *(const bf16x8*)(wa + 32); G.Bx[0] = *(const bf16x8*)wx; G.Bx[1] = *(const bf16x8*)(wx + 32);
    G.ba = p.b_a[dir * LRW + chl]; G.bx = p.b_x[dir * LRW + chl]; G.c8 = p.C8[dir * LRW + chl];
    if (FINAL) G.car = p.CAR[((size_t)(dir * NSEQ + seq) * NCHUNK + chunk) * LRW + chl]; else G.car = 0.f;
}

#ifndef PF_KK
#define PF_KK 1
#endif
__device__ __forceinline__ void raw_issue(const Params& p, u32x4 (&raw)[2][4], int item, int kk, int tp, int head, int fr, int fq) {
    const int seq = item >> 6, pos0 = (item & 63) * 64;
    const bf16_t* Zr = p.Z + (size_t)seq * SEQ * INW + head * 64 + kk * 32 + fq * 8;
#pragma unroll
    for (int t2 = 0; t2 < 2; ++t2)
#pragma unroll
        for (int k = 0; k < 4; ++k) { const int pp = pos0 + (fr >> 2) * 16 + (tp * 2 + t2) * 4 + (fr & 3) + k - 2, pc = min(max(pp, 0), SEQ - 1); raw[t2][k] = *(const u32x4*)(Zr + (size_t)pc * INW); }
}
template <bool FINAL>
__device__ __forceinline__ void scan_phase(const Params& p, LAS float* img, int wave, int lane) {
  const int head = wave, fr = lane & 15, fq = lane >> 4;
  u32x4 raw0[2][4];
  int item = blockIdx.x;
  if (!FINAL && item < NSEQ * NCHUNK) raw_issue(p, raw0, item, 0, 0, head, fr, fq);
  for (; item < NSEQ * NCHUNK; item += gridDim.x) {
    const int seq = item >> 6, chunk = item & 63;
    const size_t srow0 = (size_t)seq * SEQ, row0 = srow0 + (size_t)chunk * 64;
    const int pos0 = chunk * 64;
    GateSet nxt;
    gate_load<FINAL>(p, nxt, head, 0, 0, fr, fq, seq, chunk);
    bf16x8 Af[4][2];
    u32x4* xa = p.XA + ((size_t)item * 8 + head) * 8 * 64 + lane;
    if (FINAL) {
#pragma unroll
        for (int tb = 0; tb < 4; ++tb)
#pragma unroll
            for (int kk = 0; kk < 2; ++kk) Af[tb][kk] = __builtin_bit_cast(bf16x8, xa[(tb * 2 + kk) * 64]);
    } else {
    u32x4 rB[2][4];
    raw_issue(p, rB, item, 0, 1, head, fr, fq);
#pragma unroll
    for (int kk = 0; kk < 2; ++kk) {
        const int c0 = head * 64 + kk * 32 + fq * 8;
        f32x2 w[4][4], b[4];
#pragma unroll
        for (int k = 0; k < 4; ++k) { const f32x4 a0 = *(const f32x4*)(p.conv_w + k * LRW + c0), a1 = *(const f32x4*)(p.conv_w + k * LRW + c0 + 4);
            w[k][0] = (f32x2){a0[0], a0[1]}; w[k][1] = (f32x2){a0[2], a0[3]}; w[k][2] = (f32x2){a1[0], a1[1]}; w[k][3] = (f32x2){a1[2], a1[3]}; }
        { const f32x4 a0 = *(const f32x4*)(p.conv_b + c0), a1 = *(const f32x4*)(p.conv_b + c0 + 4);
            b[0] = (f32x2){a0[0], a0[1]}; b[1] = (f32x2){a0[2], a0[3]}; b[2] = (f32x2){a1[0], a1[1]}; b[3] = (f32x2){a1[2], a1[3]}; }
#pragma unroll
        for (int tp = 0; tp < 2; ++tp) {
            u32x4 cur[2][4];
#pragma unroll
            for (int t2 = 0; t2 < 2; ++t2)
#pragma unroll
                for (int k = 0; k < 4; ++k) cur[t2][k] = (tp == 0) ? raw0[t2][k] : rB[t2][k];
            if (kk == 0 && tp == 0) raw_issue(p, raw0, item, 1, 0, head, fr, fq);
            if (kk == 0 && tp == 1) raw_issue(p, rB, item, 1, 1, head, fr, fq);
#pragma unroll
            for (int t2 = 0; t2 < 2; ++t2) {
                const int tb = tp * 2 + t2;
                f32x2 xc[4];
#pragma unroll
                for (int e = 0; e < 4; ++e) xc[e] = b[e];
#pragma unroll
                for (int k = 0; k < 4; ++k) {
                    const int pp = pos0 + (fr >> 2) * 16 + tb * 4 + (fr & 3) + k - 2;
                    u32x4 v = cur[t2][k];
                    if (pp < 0 || pp >= SEQ) v = (u32x4){0u, 0u, 0u, 0u};
                    xc[0] += bf2(v.x) * w[k][0]; xc[1] += bf2(v.y) * w[k][1]; xc[2] += bf2(v.z) * w[k][2]; xc[3] += bf2(v.w) * w[k][3];
                }
                u32x4 pk; pk.x = pk2(xc[0].x, xc[0].y); pk.y = pk2(xc[1].x, xc[1].y); pk.z = pk2(xc[2].x, xc[2].y); pk.w = pk2(xc[3].x, xc[3].y);
                Af[tb][kk] = __builtin_bit_cast(bf16x8, pk);
            }
            __builtin_amdgcn_sched_barrier(0);
        }
    }
#pragma unroll
    for (int tb = 0; tb < 4; ++tb)
#pragma unroll
        for (int kk = 0; kk < 2; ++kk) xa[(tb * 2 + kk) * 64] = __builtin_bit_cast(u32x4, Af[tb][kk]);
    if (item + (int)gridDim.x < NSEQ * NCHUNK) raw_issue(p, raw0, item + gridDim.x, 0, 0, head, fr, fq);
    }
#pragma unroll 1
    for (int cb = 0; cb < 4; ++cb) {
        const int chl = head * 64 + cb * 16 + fr;
        f32x4 xcD[4];
        {
            bf16x8 Id[2];
#pragma unroll
            for (int kk = 0; kk < 2; ++kk)
#pragma unroll
                for (int j = 0; j < 8; ++j) Id[kk][j] = (kk * 32 + fq * 8 + j == cb * 16 + fr) ? (short)0x3F80 : (short)0;
#pragma unroll
            for (int tb = 0; tb < 4; ++tb) { xcD[tb] = (f32x4){0.f, 0.f, 0.f, 0.f}; xcD[tb] = mfma16(Af[tb][0], Id[0], xcD[tb]); xcD[tb] = mfma16(Af[tb][1], Id[1], xcD[tb]); }
        }
        float hs[16];
#pragma unroll
        for (int dir = 0; dir < 2; ++dir) {
            const GateSet G = nxt;
            if (dir == 0) gate_load<FINAL>(p, nxt, head, cb, 1, fr, fq, seq, chunk); else gate_load<FINAL>(p, nxt, head, cb < 3 ? cb + 1 : 3, 0, fr, fq, seq, chunk);
            const float nba = -1.4426950408889634f * G.ba, nbx = -1.4426950408889634f * G.bx, c8 = G.c8;
            float a[16], u[16];
#pragma unroll
            for (int tb = 0; tb < 4; ++tb) {
                f32x4 ra = (f32x4){0.f, 0.f, 0.f, 0.f}, rx = (f32x4){0.f, 0.f, 0.f, 0.f};
                ra = mfma16(Af[tb][0], G.Ba[0], ra); ra = mfma16(Af[tb][1], G.Ba[1], ra);
                rx = mfma16(Af[tb][0], G.Bx[0], rx); rx = mfma16(Af[tb][1], G.Bx[1], rx);
#pragma unroll
                for (int jp = 0; jp < 2; ++jp) {
                    f32x2 ea = (f32x2){ra[2 * jp], ra[2 * jp + 1]} * (-1.4426950408889634f) + nba;
                    f32x2 ex = (f32x2){rx[2 * jp], rx[2 * jp + 1]} * (-1.4426950408889634f) + nbx;
                    ea = (f32x2){__builtin_amdgcn_exp2f(ea.x), __builtin_amdgcn_exp2f(ea.y)}; ex = (f32x2){__builtin_amdgcn_exp2f(ex.x), __builtin_amdgcn_exp2f(ex.y)};
                    ea = ea + 1.0f; ex = ex + 1.0f;
                    const f32x2 r = (f32x2){__builtin_amdgcn_rcpf(ea.x), __builtin_amdgcn_rcpf(ea.y)}, ig = (f32x2){__builtin_amdgcn_rcpf(ex.x), __builtin_amdgcn_rcpf(ex.y)};
                    const f32x2 la = r * c8;
                    const f32x2 av = (f32x2){__builtin_amdgcn_exp2f(la.x), __builtin_amdgcn_exp2f(la.y)};
                    const f32x2 om = 1.0f - av * av;
                    const f32x2 sq = (f32x2){__builtin_amdgcn_sqrtf(om.x), __builtin_amdgcn_sqrtf(om.y)};
                    const f32x2 uu = sq * (ig * (f32x2){xcD[tb][2 * jp], xcD[tb][2 * jp + 1]});
                    a[tb * 4 + 2 * jp] = av.x; a[tb * 4 + 2 * jp + 1] = av.y; u[tb * 4 + 2 * jp] = uu.x; u[tb * 4 + 2 * jp + 1] = uu.y;
                }
            }
            float P = 1.0f, E = 0.0f;
            if (dir == 0) {
#pragma unroll
                for (int t = 0; t < 16; ++t) { E = a[t] * E + u[t]; P *= a[t]; }
            } else {
#pragma unroll
                for (int t = 15; t >= 0; --t) { E = a[t] * E + u[t]; P *= a[t]; }
            }
            float Pq[4], Eq[4];
#pragma unroll
            for (int q = 0; q < 4; ++q) { Pq[q] = __shfl(P, q * 16 + fr); Eq[q] = __shfl(E, q * 16 + fr); }
            if (!FINAL) {
                float run = 0.f, pt = 1.f;
                if (dir == 0) {
#pragma unroll
                    for (int q = 0; q < 4; ++q) { run = Eq[q] + Pq[q] * run; pt *= Pq[q]; }
                } else {
#pragma unroll
                    for (int q = 3; q >= 0; --q) { run = Eq[q] + Pq[q] * run; pt *= Pq[q]; }
                }
                if (fq == 0) p.AGG[((size_t)(dir * NSEQ + seq) * NCHUNK + chunk) * LRW + chl] = (f32x2){pt, run};
            } else {
                float run = G.car;
                if (dir == 0) {
#pragma unroll
                    for (int q = 0; q < 4; ++q) if (q < fq) run = Eq[q] + Pq[q] * run;
                    float h = run;
#pragma unroll
                    for (int t = 0; t < 16; ++t) { h = a[t] * h + u[t]; hs[t] = h; }
                } else {
#pragma unroll
                    for (int q = 3; q >= 0; --q) if (q > fq) run = Eq[q] + Pq[q] * run;
                    float h = run;
#pragma unroll
                    for (int t = 15; t >= 0; --t) { h = a[t] * h + u[t]; hs[t] += h; }
                }
            }
        }
        if (FINAL) {
#pragma unroll
            for (int t = 0; t < 16; ++t) img[(fq * 16 + t) * LDS_ROW + chl] = hs[t];
        }
    }
    if (FINAL) {
        u32x4 gb[4];
        gate_prefetch(p, row0, wave, lane, 0, gb);
        lds_barrier();
        finalize_rows<true>(p, img, row0, p.lru_g, 0, wave, lane, gb);
        lds_barrier();
    }
  }
}

constexpr int POOL_ZROW = 48;
__device__ __forceinline__ void pool_phase(const Params& p, LAS float* img, int wave, int lane) {
    for (int i = threadIdx.x; i < LDS_ROW; i += 512) img[POOL_ZROW * LDS_ROW + i] = 0.f;
    const int g = wave >> 1, nh = wave & 1, fr = lane & 15, fq = lane >> 4;
    const bf16_t* Z = p.Z;
    bf16x8 Bf[4][4]; float psc[4];
#pragma unroll
    for (int kk = 0; kk < 4; ++kk)
#pragma unroll
        for (int nb = 0; nb < 4; ++nb) Bf[kk][nb] = *(const bf16x8*)(p.WP + (size_t)g * 16384 + (nh * 64 + nb * 16 + fr) * 128 + kk * 32 + fq * 8);
#pragma unroll
    for (int nb = 0; nb < 4; ++nb) psc[nb] = p.pool_scale[g * 128 + nh * 64 + nb * 16 + fr];
    const int c = lane * 8, half = 1 << (lane >> 4);
    const f32x4 g0 = *(const f32x4*)(p.pool_g + c), g1 = *(const f32x4*)(p.pool_g + c + 4);
#define POOL_ISSUE(dst, it_) do { const int seq_ = (it_) >> 7, p0_ = ((it_) & 127) * 32; _Pragma("unroll") for (int tb = 0; tb < 3; ++tb) { \
        const int pc_ = min(max(p0_ - 8 + tb * 16 + fr, 0), SEQ - 1); const bf16_t* zr_ = Z + ((size_t)seq_ * SEQ + pc_) * INW + 2 * LRW + g * 128 + fq * 8; \
        _Pragma("unroll") for (int kk = 0; kk < 4; ++kk) dst[tb][kk] = *(const u32x4*)(zr_ + kk * 32); } } while (0)
    u32x4 vn[3][4];
    if ((int)blockIdx.x < NSEQ * (SEQ / 32)) POOL_ISSUE(vn, (int)blockIdx.x);
    for (int item = blockIdx.x; item < NSEQ * (SEQ / 32); item += gridDim.x) {
        const int seq = item >> 7, pos0 = (item & 127) * 32;
        const size_t srow0 = (size_t)seq * SEQ;
        u32x4 v[3][4];
#pragma unroll
        for (int tb = 0; tb < 3; ++tb) {
            const int pp = pos0 - 8 + tb * 16 + fr;
#pragma unroll
            for (int kk = 0; kk < 4; ++kk) { v[tb][kk] = vn[tb][kk]; if (pp < 0 || pp >= SEQ) v[tb][kk] = (u32x4){0u, 0u, 0u, 0u}; }
        }
        if (item + (int)gridDim.x < NSEQ * (SEQ / 32)) POOL_ISSUE(vn, item + (int)gridDim.x);
#pragma unroll
        for (int tb = 0; tb < 3; ++tb) {
            f32x4 acc[4];
#pragma unroll
            for (int nb = 0; nb < 4; ++nb) acc[nb] = (f32x4){0.f, 0.f, 0.f, 0.f};
#pragma unroll
            for (int kk = 0; kk < 4; ++kk) { const bf16x8 Afr = __builtin_bit_cast(bf16x8, v[tb][kk]);
#pragma unroll
                for (int nb = 0; nb < 4; ++nb) acc[nb] = mfma16(Afr, Bf[kk][nb], acc[nb]); }
#pragma unroll
            for (int nb = 0; nb < 4; ++nb)
#pragma unroll
                for (int j = 0; j < 4; ++j) img[(tb * 16 + fq * 4 + j) * LDS_ROW + g * 128 + nh * 64 + nb * 16 + fr] = acc[nb][j] * psc[nb];
        }
        lds_barrier();
        f32x4 d0[4], d1[4]; float ss[4];
        {
            const int row0 = wave * 4 + 8;
            f32x4 s0 = (f32x4){0.f, 0.f, 0.f, 0.f}, s1 = s0;
#pragma unroll
            for (int d = -8; d < 8; ++d) {
                const int r = (d >= -half && d < half) ? row0 + d : POOL_ZROW;
                s0 += *(const LAS f32x4*)(img + r * LDS_ROW + c); s1 += *(const LAS f32x4*)(img + r * LDS_ROW + c + 4);
            }
#pragma unroll
            for (int i = 0; i < 4; ++i) {
                const int row = row0 + i, pos = pos0 + wave * 4 + i;
                if (i > 0) {
                    s0 += *(const LAS f32x4*)(img + (row - 1 + half) * LDS_ROW + c) - *(const LAS f32x4*)(img + (row - 1 - half) * LDS_ROW + c);
                    s1 += *(const LAS f32x4*)(img + (row - 1 + half) * LDS_ROW + c + 4) - *(const LAS f32x4*)(img + (row - 1 - half) * LDS_ROW + c + 4);
                }
                const int lo = max(pos - half, 0), hi = min(pos + half, SEQ);
                const float inv = 1.0f / (float)(hi - lo);
                d0[i] = s0 * inv - *(const LAS f32x4*)(img + row * LDS_ROW + c); d1[i] = s1 * inv - *(const LAS f32x4*)(img + row * LDS_ROW + c + 4);
                ss[i] = (d0[i][0] * d0[i][0] + d0[i][1] * d0[i][1]) + (d0[i][2] * d0[i][2] + d0[i][3] * d0[i][3]) + (d1[i][0] * d1[i][0] + d1[i][1] * d1[i][1]) + (d1[i][2] * d1[i][2] + d1[i][3] * d1[i][3]);
            }
        }
#pragma unroll
        for (int o = 1; o < 64; o <<= 1) {
#pragma unroll
            for (int i = 0; i < 4; ++i) ss[i] += __shfl_xor(ss[i], o);
        }
#pragma unroll
        for (int i = 0; i < 4; ++i) {
            const float sc = rsqrtf(ss[i] * (1.0f / LRW) + EPS);
            u32x4 w; w.x = pk2(d0[i][0] * sc * g0[0], d0[i][1] * sc * g0[1]); w.y = pk2(d0[i][2] * sc * g0[2], d0[i][3] * sc * g0[3]);
            w.z = pk2(d1[i][0] * sc * g1[0], d1[i][1] * sc * g1[1]); w.w = pk2(d1[i][2] * sc * g1[2], d1[i][3] * sc * g1[3]);
            *(u32x4*)(p.XN + (srow0 + pos0 + wave * 4 + i) * DM + LRW + c) = w;
        }
        lds_barrier();
    }
}

__device__ __forceinline__ void phase_carries(const Params& p) {
    for (int id = blockIdx.x * 512 + threadIdx.x; id < 2 * NSEQ * LRW; id += gridDim.x * 512) {
        const int dir = id / (NSEQ * LRW), rem = id % (NSEQ * LRW), seq = rem / LRW, ch = rem % LRW;
        const size_t base = (size_t)(dir * NSEQ + seq) * NCHUNK * LRW + ch;
        float run = 0.f;
#pragma unroll 1
        for (int c0 = 0; c0 < NCHUNK; c0 += 16) {
            f32x2 pe[16];
#pragma unroll
            for (int i = 0; i < 16; ++i) { const int c = dir == 0 ? c0 + i : NCHUNK - 1 - c0 - i; pe[i] = p.AGG[base + (size_t)c * LRW]; }
#pragma unroll
            for (int i = 0; i < 16; ++i) { const int c = dir == 0 ? c0 + i : NCHUNK - 1 - c0 - i; p.CAR[base + (size_t)c * LRW] = run; run = pe[i].y + pe[i].x * run; }
        }
    }
}

#define XB_TMO      128
#define XB_XCNT(j)  (256  + 64 * (j))
#define XB_XSUB(j)  (1280 + 64 * (j))
#define XB_XGEN(j)  (2304 + 64 * (j))
#define XB_TOP      3328
#define XB_TOPGEN   3392
#define XCD_BAR_WORDS 3456
#define XB_SPIN_CAP (1u << 18)
__device__ __forceinline__ unsigned xb_ld(unsigned* p)              { return __hip_atomic_load(p, __ATOMIC_RELAXED, __HIP_MEMORY_SCOPE_AGENT); }
__device__ __forceinline__ unsigned xb_add(unsigned* p, unsigned v) { return __hip_atomic_fetch_add(p, v, __ATOMIC_RELAXED, __HIP_MEMORY_SCOPE_AGENT); }
__device__ __forceinline__ unsigned xb_xcc_id() { return (unsigned)__builtin_amdgcn_s_getreg((3 << 11) | 20) & 0xFu; }
#define XB_SPIN(cond, bar) do { unsigned _sp = 0; while (cond) { __builtin_amdgcn_s_sleep(1); \
    if ((++_sp & 255u) == 0u) { if (xb_ld(&(bar)[XB_TMO])) break; if (_sp > XB_SPIN_CAP) { atomicAdd(&(bar)[XB_TMO], 1u); break; } } } } while (0)
struct XcdBarrier { unsigned* bar; unsigned x; volatile LAS unsigned* st; };
__device__ __forceinline__ XcdBarrier xcd_barrier_post(unsigned* bar, volatile LAS unsigned* st) {
    XcdBarrier b; b.bar = bar; b.x = xb_xcc_id(); b.st = st;
    if (threadIdx.x == 0) (void)xb_add(&bar[XB_XCNT(b.x)], 1u);
    return b;
}
__device__ __forceinline__ void xcd_barrier_complete(unsigned* bar, unsigned x, unsigned& nloc, unsigned& nx) {
    const unsigned G = gridDim.x * gridDim.y * gridDim.z;
    unsigned sum, cnt, mine, sp = 0u;
    for (;;) {
        sum = 0u; cnt = 0u; mine = 0u;
#pragma unroll
        for (unsigned j = 0; j < 16; ++j) { const unsigned c = xb_ld(&bar[XB_XCNT(j)]); sum += c; cnt += (c > 0u) ? 1u : 0u; mine = (j == x) ? c : mine; }
        if (sum == G) break;
        __builtin_amdgcn_s_sleep(1);
        if ((++sp & 255u) == 0u) { if (xb_ld(&bar[XB_TMO])) break; if (sp > XB_SPIN_CAP) { atomicAdd(&bar[XB_TMO], 1u); break; } }
    }
    nloc = mine > 0u ? mine : 1u; nx = cnt > 0u ? cnt : 1u;
}
__device__ __forceinline__ void xcd_barrier(const XcdBarrier& b) {
    asm volatile("s_waitcnt vmcnt(0)" ::: "memory");
    __syncthreads();
    if (threadIdx.x == 0) {
        unsigned* bar = b.bar;
        __builtin_amdgcn_s_waitcnt(0);
        unsigned nloc = b.st[0], nx = b.st[1];
        if (nloc == 0u) { xcd_barrier_complete(bar, b.x, nloc, nx); b.st[0] = nloc; b.st[1] = nx; }
        const unsigned old = xb_add(&bar[XB_XSUB(b.x)], 1u);
        const unsigned gen = old / nloc;
        if (old + 1u == (gen + 1u) * nloc) {
            __builtin_amdgcn_fence(__ATOMIC_RELEASE, "agent");
            asm volatile("s_waitcnt vmcnt(0)" ::: "memory");
            const unsigned og = xb_add(&bar[XB_TOP], 1u);
            const unsigned tg = og / nx;
            if (og + 1u == (tg + 1u) * nx) xb_add(&bar[XB_TOPGEN], 1u);
            else XB_SPIN(xb_ld(&bar[XB_TOPGEN]) == tg, bar);
            __builtin_amdgcn_fence(__ATOMIC_ACQUIRE, "agent");
            xb_add(&bar[XB_XGEN(b.x)], 1u);
            asm volatile("s_waitcnt vmcnt(0)" ::: "memory");
        } else {
            XB_SPIN(xb_ld(&bar[XB_XGEN(b.x)]) == gen, bar);
            __builtin_amdgcn_fence(__ATOMIC_ACQUIRE, "agent");
            asm volatile("s_waitcnt vmcnt(0)" ::: "memory");
        }
    }
    __syncthreads();
}

constexpr int N_PHASES = 13;
template <class Epi>
__device__ __forceinline__ void run_gemm(LAS unsigned char* lds, const bf16_t* A, const bf16_t* Bt, int N, int K, const Epi& E) {
    pg8::Gemm g{A, Bt, T_ROWS, N, K};
    pg8::StaticOrder S; S.init(g.M, g.N, (int)gridDim.x, (int)blockIdx.x);
    pg8::gemm_phase(lds, g, S, E);
}
template <bool COOP>
__global__ __launch_bounds__(512, 2) void mk_fwd(Params p, int ph_lo, int ph_hi) {
    extern __shared__ __attribute__((aligned(16))) unsigned char shm[];
    LAS unsigned char* lds = (LAS unsigned char*)shm;
    XcdBarrier xb{};
    if (COOP) {
        volatile LAS unsigned* st = (volatile LAS unsigned*)(lds + LDS_BYTES);
        if (threadIdx.x == 0) { st[0] = 0u; st[1] = 0u; }
        __syncthreads();
        xb = xcd_barrier_post(p.BAR, st);
        if (ph_hi > N_PHASES) cg::this_grid().sync();
    }
#define MK_ON(k) (ph_lo <= (k) && (k) < ph_hi)
#define MK_SYNC(k) do { if (COOP) { if (ph_lo <= (k) && (k) + 1 < ph_hi) xcd_barrier(xb); } } while (0)
#define MK_WL const int tid_ = opaque_tid(), wave = __builtin_amdgcn_readfirstlane(tid_ >> 6), lane = tid_ & 63
    if ((MK_MASK & 4) && MK_ON(0)) { MK_WL; phase_prep(p, lds, wave, lane); }
    MK_SYNC(0);
    if ((MK_MASK & 1) && MK_ON(1)) run_gemm(lds, p.XN, p.W1, 2 * DFF, DM, pg8::EpiSwiGLU{p.H});
    MK_SYNC(1);
    if ((MK_MASK & 2) && MK_ON(2)) run_gemm(lds, p.H, p.W2, DM, DFF, pg8::EpiBf16{p.XN, DM});
    MK_SYNC(2);
    if ((MK_MASK & 8) && MK_ON(3)) { MK_WL; phase_rows<0>(p, wave, lane); }
    MK_SYNC(3);
    if ((MK_MASK & 2) && MK_ON(4)) run_gemm(lds, p.XN, p.W3, INW, DM, pg8::EpiBf16{p.Z, INW});
    MK_SYNC(4);
    if ((MK_MASK & 16) && MK_ON(5)) { MK_WL;
        scan_phase<false>(p, (LAS float*)lds, wave, lane);
        pool_phase(p, (LAS float*)lds, wave, lane); }
    MK_SYNC(5);
    if ((MK_MASK & 32) && MK_ON(6)) phase_carries(p);
    MK_SYNC(6);
    if ((MK_MASK & 64) && MK_ON(7)) { MK_WL; scan_phase<true>(p, (LAS float*)lds, wave, lane); }
    MK_SYNC(7);
    if ((MK_MASK & 2) && MK_ON(8)) run_gemm(lds, p.XN, p.W4, DM, DM, pg8::EpiBf16{p.O, DM});
    MK_SYNC(8);
    if ((MK_MASK & 8) && MK_ON(9)) { MK_WL; phase_rows<1>(p, wave, lane); }
    MK_SYNC(9);
    if ((MK_MASK & 1) && MK_ON(10)) run_gemm(lds, p.XN, p.W5, 2 * DFF, DM, pg8::EpiSwiGLU{p.H});
    MK_SYNC(10);
    if ((MK_MASK & 2) && MK_ON(11)) run_gemm(lds, p.H, p.W6, DM, DFF, pg8::EpiBf16{p.XN, DM});
    MK_SYNC(11);
    if ((MK_MASK & 8) && MK_ON(12)) { MK_WL; phase_rows<2>(p, wave, lane); }
}

extern "C" void kernel_launch(void* const* d_in, const int* in_sizes, int n_in, void* d_out, int out_size, void* d_ws, size_t ws_size, hipStream_t stream) {
    static int grid = 0;
    if (grid == 0) {
        if (n_in != 25 || out_size != T_ROWS * DM || ws_size < WS_TOTAL) { fprintf(stderr, "kernel_launch: unexpected shapes (n_in %d out %d ws %zu need %zu)\n", n_in, out_size, ws_size, (size_t)WS_TOTAL); grid = -1; return; }
        int dev = 0, cus = 0, per_cu = 0;
        hipGetDevice(&dev); hipDeviceGetAttribute(&cus, hipDeviceAttributeMultiprocessorCount, dev);
        hipFuncSetAttribute((const void*)mk_fwd<true>, hipFuncAttributeMaxDynamicSharedMemorySize, LDS_TOTAL);
        hipFuncSetAttribute((const void*)mk_fwd<false>, hipFuncAttributeMaxDynamicSharedMemorySize, LDS_TOTAL);
        hipOccupancyMaxActiveBlocksPerMultiprocessor(&per_cu, (const void*)mk_fwd<true>, 512, LDS_TOTAL);
        if (per_cu < 1) per_cu = 1;
        grid = cus * per_cu;
        (void)hipGetLastError();
    }
    if (grid < 0) return;
    Params p{};
    const float* const* in = (const float* const*)d_in;
    p.xp = in[0]; p.xs = in[1]; p.f1_pre = in[2]; p.f1_post = in[3]; p.f1_win = in[4]; p.f1_wout = in[5];
    p.mx_pre = in[6]; p.mx_post = in[7]; p.w_in = in[8]; p.conv_w = in[9]; p.conv_b = in[10]; p.w_a = in[11]; p.b_a = in[12]; p.w_x = in[13]; p.b_x = in[14];
    p.lam = in[15]; p.lru_g = in[16]; p.pool_w = in[17]; p.pool_scale = in[18]; p.pool_g = in[19]; p.w_out = in[20];
    p.f2_pre = in[21]; p.f2_post = in[22]; p.f2_win = in[23]; p.f2_wout = in[24];
    p.out = (float*)d_out;
    unsigned char* ws = (unsigned char*)d_ws;
    p.W1 = (bf16_t*)(ws + WS_W1); p.W2 = (bf16_t*)(ws + WS_W2); p.W3 = (bf16_t*)(ws + WS_W3); p.W4 = (bf16_t*)(ws + WS_W4); p.W5 = (bf16_t*)(ws + WS_W5); p.W6 = (bf16_t*)(ws + WS_W6);
    p.WG = (bf16_t*)(ws + WS_WG); p.WP = (bf16_t*)(ws + WS_WP); p.XN = (bf16_t*)(ws + WS_XN); p.XR = (bf16_t*)(ws + WS_XR); p.O = (bf16_t*)(ws + WS_H); p.H = (bf16_t*)(ws + WS_H); p.Z = (bf16_t*)(ws + WS_Z);
    p.AGG = (f32x2*)(ws + WS_AGG); p.CAR = (float*)(ws + WS_CAR); p.C8 = (float*)(ws + WS_C8); p.BAR = (unsigned*)(ws + WS_BAR); p.XA = (u32x4*)(ws + WS_XA);
#if MK_COOP
    (void)hipMemsetAsync(ws + WS_BAR, 0, XCD_BAR_WORDS * 4, stream);
    int lo = 0, hi = N_PHASES;
    void* args[] = {&p, &lo, &hi};
    hipError_t e = hipLaunchCooperativeKernel((const void*)mk_fwd<true>, dim3(grid), dim3(512), args, LDS_TOTAL, stream);
    if (e != hipSuccess) fprintf(stderr, "cooperative launch failed: %s (grid %d)\n", hipGetErrorString(e), grid);
#else
    for (int ph = 0; ph < N_PHASES; ++ph) hipLaunchKernelGGL(mk_fwd<false>, dim3(grid), dim3(512), LDS_TOTAL, stream, p, ph, ph + 1);
#endif
}
```

```cpp
#include <hip/hip_runtime.h>
#include <hip/hip_cooperative_groups.h>
#include <cstdio>
namespace cg = cooperative_groups;

#ifndef MK_COOP
#define MK_COOP 1
#endif
#ifndef MK_MASK
#define MK_MASK 0xff
#endif

#define LAS __attribute__((address_space(3)))
typedef unsigned short bf16_t;
typedef short bf16x8 __attribute__((ext_vector_type(8)));
typedef float f32x4 __attribute__((ext_vector_type(4)));
typedef float f32x2 __attribute__((ext_vector_type(2)));
typedef unsigned u32x4 __attribute__((ext_vector_type(4)));
typedef unsigned u32x2 __attribute__((ext_vector_type(2)));

constexpr int T_ROWS = 98304, TP_ROWS = 32768, SEQ = 4096, NSEQ = 24, DM = 1024, DFF = 2816, INW = 1536, LRW = 512;
constexpr int NCHUNK = 64;
constexpr float EPS = 1e-6f;
constexpr int LDS_ROW = 516;
constexpr int LDS_BYTES = 64 * LDS_ROW * 4;

constexpr size_t SZ_W1 = (size_t)2 * DFF * DM * 2, SZ_W2 = (size_t)DM * DFF * 2, SZ_W3 = (size_t)INW * DM * 2, SZ_W4 = (size_t)DM * DM * 2;
constexpr size_t WS_W1 = 0, WS_W2 = WS_W1 + SZ_W1, WS_W3 = WS_W2 + SZ_W2, WS_W4 = WS_W3 + SZ_W3, WS_W5 = WS_W4 + SZ_W4, WS_W6 = WS_W5 + SZ_W1;
constexpr size_t WS_WG = WS_W6 + SZ_W2;
constexpr size_t WS_WP = WS_WG + (size_t)2 * 2 * 8 * 64 * 64 * 2;
constexpr size_t WS_C8 = WS_WP + (size_t)4 * 128 * 128 * 2;
constexpr size_t WS_XN = WS_C8 + 4096;
constexpr size_t WS_XR = WS_XN + (size_t)T_ROWS * DM * 2;
constexpr size_t WS_H = WS_XR + (size_t)T_ROWS * DM * 2;
constexpr size_t WS_Z = WS_H;
constexpr size_t WS_AGG = WS_Z + (size_t)T_ROWS * INW * 2;
constexpr size_t WS_CAR = WS_AGG + (size_t)2 * NSEQ * NCHUNK * LRW * 8;
constexpr size_t WS_XA = WS_CAR + (size_t)2 * NSEQ * NCHUNK * LRW * 4;
constexpr size_t WS_END = WS_H + (size_t)T_ROWS * DFF * 2;
constexpr size_t WS_BAR = WS_END;
constexpr size_t WS_TOTAL = WS_BAR + 16384;
constexpr int LDS_TOTAL = LDS_BYTES + 16;
static_assert(WS_XA + (size_t)NSEQ * NCHUNK * 8 * 8 * 64 * 16 <= WS_END, "mixer scratch must fit inside the H region");

struct Params {
    const float *xp, *xs;
    const float *f1_pre, *f1_post, *f1_win, *f1_wout;
    const float *mx_pre, *mx_post, *w_in, *conv_w, *conv_b, *w_a, *b_a, *w_x, *b_x, *lam, *lru_g, *pool_w, *pool_scale, *pool_g, *w_out;
    const float *f2_pre, *f2_post, *f2_win, *f2_wout;
    float* out;
    bf16_t *W1, *W2, *W3, *W4, *W5, *W6, *WG, *WP, *XN, *XR, *O, *H, *Z;
    f32x2* AGG; float* CAR; float* C8; unsigned* BAR; u32x4* XA;
};

__device__ __forceinline__ unsigned pk2(float lo, float hi) { unsigned r; asm volatile("v_cvt_pk_bf16_f32 %0, %1, %2" : "=v"(r) : "v"(lo), "v"(hi)); return r; }
__device__ __forceinline__ float bflo(unsigned v) { return __uint_as_float(v << 16); }
__device__ __forceinline__ float bfhi(unsigned v) { return __uint_as_float(v & 0xffff0000u); }
__device__ __forceinline__ float wave_sum(float v) {
#pragma unroll
    for (int o = 1; o < 64; o <<= 1) v += __shfl_xor(v, o);
    return v;
}
__device__ __forceinline__ float fsigmoid(float x) { return __builtin_amdgcn_rcpf(1.0f + __builtin_amdgcn_exp2f(-1.4426950408889634f * x)); }
__device__ __forceinline__ float fsilu(float x) { return x * fsigmoid(x); }
__device__ __forceinline__ float fgelu_tanh(float x) { const float y = 0.7978845608028654f * (x + 0.044715f * x * x * x); return x * fsigmoid(2.0f * y); }
__device__ __forceinline__ int opaque_tid() { int t = threadIdx.x; asm volatile("" : "+v"(t)); return t; }
__device__ __forceinline__ f32x2 rcp2(f32x2 v) { return (f32x2){__builtin_amdgcn_rcpf(v.x), __builtin_amdgcn_rcpf(v.y)}; }
__device__ __forceinline__ f32x2 exp2_2(f32x2 v) { return (f32x2){__builtin_amdgcn_exp2f(v.x), __builtin_amdgcn_exp2f(v.y)}; }
__device__ __forceinline__ f32x2 silu_mul2(f32x2 g, f32x2 u) { return (g * u) * rcp2(exp2_2(g * (-1.4426950408889634f)) + 1.0f); }
__device__ __forceinline__ f32x2 gelu_mul2(f32x2 x, f32x2 s) {
    const f32x2 t = (x * x) * 0.044715f + 1.0f, arg = (x * t) * (-2.0f * 0.7978845608028654f * 1.4426950408889634f);
    return (s * x) * rcp2(exp2_2(arg) + 1.0f); }
__device__ __forceinline__ f32x2 bf2(unsigned v) { return (f32x2){__uint_as_float(v << 16), __uint_as_float(v & 0xffff0000u)}; }
__device__ __forceinline__ void lds_barrier() { asm volatile("s_waitcnt lgkmcnt(0)\n\ts_barrier" ::: "memory"); }
#define LDS_WAIT() asm volatile("s_waitcnt lgkmcnt(0)" ::: "memory")

namespace pg8 {
constexpr int BM = 256, BK = 64, HALF = 128, HTB = HALF * BK * 2, STAGE_BYTES = 8 * HTB, NXCD = 8, WGM = 8;
__host__ __device__ __forceinline__ int lds_byte(int r, int c) { const int st = (r >> 4) * 2 + (c >> 5), rr = r & 15, cc = c & 31, ob = rr * 64 + cc * 2; return st * 1024 + (ob ^ (((ob >> 9) & 1) << 5)); }
__host__ __device__ __forceinline__ void stage_rc(int b, int& R, int& C) { const int st = b / 1024, sb = b % 1024, swz = sb ^ (((sb >> 9) & 1) << 5); R = (st >> 1) * 16 + swz / 64; C = (st & 1) * 32 + (swz % 64) / 2; }
__host__ __device__ __forceinline__ int perm32(int rho) { const int n = rho >> 4, i = rho & 15; return 8 * (i >> 2) + 4 * n + (i & 3); }
struct Unit { int pm, pn; };
struct Gemm { const bf16_t* A; const bf16_t* Bt; int M, N, K; };
struct StaticOrder {
    int nM, nN, nwg, G, c;
    __host__ __device__ void init(int M, int N, int G_, int c_) { nM = M / BM; nN = N / BM; nwg = nM * nN; G = G_; c = c_; }
    __host__ __device__ bool next(int i, Unit& u) const {
        const long L = (long)i * G + c; if (L >= nwg) return false;
        int wgid = (int)L; { const int q = nwg / NXCD, r = nwg % NXCD, xcd = wgid % NXCD, off = wgid / NXCD; wgid = (xcd < r ? xcd * (q + 1) : r * (q + 1) + (xcd - r) * q) + off; }
        const int nig = WGM * nN, gid = wgid / nig, fm = gid * WGM, gsz = (nM - fm) < WGM ? (nM - fm) : WGM;
        u.pm = fm + ((wgid % nig) % gsz); u.pn = (wgid % nig) / gsz; return true;
    }
    __device__ __forceinline__ void a_ready(const Unit&) const {}
    __device__ __forceinline__ void done(const Unit&) const {}
};

struct EpiBf16 {
    static constexpr bool PERM = true;
    bf16_t* O; int ldc;
    __device__ __forceinline__ void operator()(const f32x4 (&acc)[2][2][4][2], const Unit& u, int wr, int wc, int fr, int fq) const {
        const int row0 = u.pm * BM + wr * 64 + fr, col0 = u.pn * BM + wc * 32 + 8 * fq;
#pragma unroll
        for (int ai = 0; ai < 2; ++ai)
#pragma unroll
            for (int m = 0; m < 4; ++m) { bf16_t* rowp = O + (size_t)(row0 + ai * HALF + m * 16) * ldc + col0;
#pragma unroll
                for (int bj = 0; bj < 2; ++bj) { const f32x4 v0 = acc[ai][bj][m][0], v1 = acc[ai][bj][m][1];
                    u32x4 w; w.x = pk2(v0[0], v0[1]); w.y = pk2(v0[2], v0[3]); w.z = pk2(v1[0], v1[1]); w.w = pk2(v1[2], v1[3]);
                    *(u32x4*)(rowp + bj * HALF) = w; } }
    }
};
struct EpiSwiGLU {
    static constexpr bool PERM = true;
    bf16_t* O;
    __device__ __forceinline__ void operator()(const f32x4 (&acc)[2][2][4][2], const Unit& u, int wr, int wc, int fr, int fq) const {
        const int row0 = u.pm * BM + wr * 64 + fr, col0 = u.pn * HALF + wc * 32 + 8 * fq;
#pragma unroll
        for (int ai = 0; ai < 2; ++ai)
#pragma unroll
            for (int m = 0; m < 4; ++m) { bf16_t* rowp = O + (size_t)(row0 + ai * HALF + m * 16) * DFF + col0;
                const f32x4 g0 = acc[ai][0][m][0], g1 = acc[ai][0][m][1], u0 = acc[ai][1][m][0], u1 = acc[ai][1][m][1];
                const f32x2 h0 = silu_mul2((f32x2){g0[0], g0[1]}, (f32x2){u0[0], u0[1]}), h1 = silu_mul2((f32x2){g0[2], g0[3]}, (f32x2){u0[2], u0[3]});
                const f32x2 h2 = silu_mul2((f32x2){g1[0], g1[1]}, (f32x2){u1[0], u1[1]}), h3 = silu_mul2((f32x2){g1[2], g1[3]}, (f32x2){u1[2], u1[3]});
                u32x4 w; w.x = pk2(h0.x, h0.y); w.y = pk2(h1.x, h1.y); w.z = pk2(h2.x, h2.y); w.w = pk2(h3.x, h3.y);
                __builtin_nontemporal_store(w, (u32x4*)rowp); }
    }
};

template <class Epi, class Sched>
__device__ __forceinline__ void gemm_phase(LAS unsigned char* lds, const Gemm g, const Sched& S, const Epi& E) {
    const int tid = opaque_tid(), wid = __builtin_amdgcn_readfirstlane(tid >> 6), lane = tid & 63, wr = wid >> 2, wc = wid & 3, fr = lane & 15, fq = lane >> 4;
    const int K = g.K, nt = K / BK;
    unsigned voffA[2], voffB[2];
#pragma unroll
    for (int i = 0; i < 2; ++i) { int R, C; stage_rc(tid * 16 + i * 8192, R, C); const int Rb = Epi::PERM ? ((R & ~31) + perm32(R & 31)) : R;
        voffA[i] = (unsigned)(R * K + C) * 2u; voffB[i] = (unsigned)(Rb * K + C) * 2u; }
    const size_t kstep = (size_t)(BK * 2);
    const size_t hstep = (size_t)HALF * K * 2;
    const size_t tstep = 2 * hstep;
    const unsigned ldsw = (unsigned)wid * 1024u;
    const int aoff = lds_byte(wr * 64 + fr, fq * 8), boff = lds_byte(wc * 32 + fr, fq * 8);
#define PG8_SA(b, h) (((b) * 2 + (h)) * HTB)
#define PG8_SB(b, h) ((4 + (b) * 2 + (h)) * HTB)
#define PG8_STAGE(bufoff, gbase, voff) do { _Pragma("unroll") for (int _i = 0; _i < 2; ++_i) \
        __builtin_amdgcn_global_load_lds((const unsigned*)((const char*)(gbase) + (voff)[_i]), (LAS unsigned*)(lds + (bufoff) + ldsw + _i * 8192), 16, 0, 0); } while (0)
#define PG8_LDA(dst, b, h) do { _Pragma("unroll") for (int m = 0; m < 4; ++m) _Pragma("unroll") for (int k = 0; k < 2; ++k) dst[m][k] = *(const LAS bf16x8*)(lds + PG8_SA(b, h) + aoff + m * 2048 + k * 1024); } while (0)
#define PG8_LDB(dst, b, h) do { _Pragma("unroll") for (int n = 0; n < 2; ++n) _Pragma("unroll") for (int k = 0; k < 2; ++k) dst[n][k] = *(const LAS bf16x8*)(lds + PG8_SB(b, h) + boff + n * 2048 + k * 1024); } while (0)
#define PG8_MMA(ai, bj, At, Bt) do { __builtin_amdgcn_s_setprio(1); _Pragma("unroll") for (int m = 0; m < 4; ++m) _Pragma("unroll") for (int n = 0; n < 2; ++n) _Pragma("unroll") for (int k = 0; k < 2; ++k) \
        acc[ai][bj][m][n] = __builtin_amdgcn_mfma_f32_16x16x32_bf16(Bt[n][k], At[m][k], acc[ai][bj][m][n], 0, 0, 0); __builtin_amdgcn_s_setprio(0); } while (0)
#define PG8_WAIT_V(n) asm volatile("s_waitcnt vmcnt(" #n ")" ::: "memory")
#define PG8_WAIT_L(n) asm volatile("s_waitcnt lgkmcnt(" #n ")" ::: "memory")
#define PG8_BAR __builtin_amdgcn_s_barrier()
#define PG8_SCHED __builtin_amdgcn_sched_barrier(0)
    Unit cur, nxt; int ui = 0;
    if (!S.next(0, cur)) return;
    f32x4 acc[2][2][4][2];
#pragma unroll
    for (int a = 0; a < 2; ++a)
#pragma unroll
        for (int b = 0; b < 2; ++b)
#pragma unroll
            for (int m = 0; m < 4; ++m)
#pragma unroll
                for (int n = 0; n < 2; ++n) acc[a][b][m][n] = (f32x4){0.f, 0.f, 0.f, 0.f};
    bf16x8 At[4][2], B0[2][2], B1[2][2];
    const char* cA = (const char*)g.A + (size_t)cur.pm * tstep; const char* cB = (const char*)g.Bt + (size_t)cur.pn * tstep;
    S.a_ready(cur);
    PG8_STAGE(PG8_SB(0, 0), cB, voffB); PG8_STAGE(PG8_SA(0, 0), cA, voffA); PG8_STAGE(PG8_SB(0, 1), cB + hstep, voffB); PG8_STAGE(PG8_SA(0, 1), cA + hstep, voffA);
    if (wr == 1) PG8_BAR;
    PG8_WAIT_V(4); PG8_BAR;
    PG8_STAGE(PG8_SB(1, 0), cB + kstep, voffB); PG8_STAGE(PG8_SA(1, 0), cA + kstep, voffA); PG8_STAGE(PG8_SB(1, 1), cB + hstep + kstep, voffB);
    PG8_WAIT_V(6); PG8_BAR;
    for (;;) {
        const bool has_next = S.next(ui + 1, nxt);
        const char* nA = has_next ? (const char*)g.A + (size_t)nxt.pm * tstep : cA; const char* nB = has_next ? (const char*)g.Bt + (size_t)nxt.pn * tstep : cB;
        for (int t = 0; t < nt; t += 2) {
            const bool last = (t == nt - 2);
            const char* a1 = cA + (size_t)(t + 1) * kstep;
            const char* a2 = last ? nA : cA + (size_t)(t + 2) * kstep; const char* b2 = last ? nB : cB + (size_t)(t + 2) * kstep;
            const char* a3 = a2 + kstep; const char* b3 = b2 + kstep;
            if (last && has_next) S.a_ready(nxt);
            PG8_LDB(B0, 0, 0); PG8_SCHED; PG8_LDA(At, 0, 0); PG8_STAGE(PG8_SA(1, 1), a1 + hstep, voffA);
            PG8_WAIT_L(8); PG8_BAR; PG8_WAIT_L(0); PG8_MMA(0, 0, At, B0); PG8_BAR; PG8_SCHED;
            PG8_LDB(B1, 0, 1); PG8_STAGE(PG8_SB(0, 0), b2, voffB);
            PG8_BAR; PG8_WAIT_L(0); PG8_MMA(0, 1, At, B1); PG8_BAR;
            PG8_LDA(At, 0, 1); PG8_STAGE(PG8_SA(0, 0), a2, voffA);
            PG8_BAR; PG8_WAIT_L(0); PG8_MMA(1, 0, At, B0); PG8_BAR; PG8_SCHED;
            PG8_STAGE(PG8_SB(0, 1), b2 + hstep, voffB);
            PG8_WAIT_V(6); PG8_BAR; PG8_MMA(1, 1, At, B1); PG8_BAR;
            PG8_LDB(B0, 1, 0); PG8_SCHED; PG8_LDA(At, 1, 0); PG8_STAGE(PG8_SA(0, 1), a2 + hstep, voffA);
            PG8_WAIT_L(8); PG8_BAR; PG8_WAIT_L(0); PG8_MMA(0, 0, At, B0); PG8_BAR; PG8_SCHED;
            PG8_LDB(B1, 1, 1); PG8_STAGE(PG8_SB(1, 0), b3, voffB);
            PG8_BAR; PG8_WAIT_L(0); PG8_MMA(0, 1, At, B1); PG8_BAR;
            PG8_LDA(At, 1, 1); PG8_STAGE(PG8_SA(1, 0), a3, voffA);
            PG8_BAR; PG8_WAIT_L(0); PG8_MMA(1, 0, At, B0); PG8_BAR; PG8_SCHED;
            PG8_STAGE(PG8_SB(1, 1), b3 + hstep, voffB);
            PG8_WAIT_V(6); PG8_BAR; PG8_MMA(1, 1, At, B1); PG8_BAR;
        }
        E(acc, cur, wr, wc, fr, fq); S.done(cur);
        if (!has_next) break;
#pragma unroll
        for (int a = 0; a < 2; ++a)
#pragma unroll
            for (int b = 0; b < 2; ++b)
#pragma unroll
                for (int m = 0; m < 4; ++m)
#pragma unroll
                    for (int n = 0; n < 2; ++n) acc[a][b][m][n] = (f32x4){0.f, 0.f, 0.f, 0.f};
        cur = nxt; cA = nA; cB = nB; ++ui;
    }
    PG8_WAIT_V(0);
    if (wr == 0) PG8_BAR;
    PG8_BAR;
#undef PG8_SA
#undef PG8_SB
#undef PG8_STAGE
#undef PG8_LDA
#undef PG8_LDB
#undef PG8_MMA
#undef PG8_WAIT_V
#undef PG8_WAIT_L
#undef PG8_BAR
#undef PG8_SCHED
}
}

__device__ __forceinline__ void tr_item(const float* W, int ldw, int k0, int n0, bf16_t* WT, int ldt, int drow0, LAS float* scr, int lane) {
    float tmp[32];
#pragma unroll
    for (int i = 0; i < 32; ++i) tmp[i] = W[(size_t)(k0 + 2 * i + (lane >> 5)) * ldw + n0 + (lane & 31)];
#pragma unroll
    for (int i = 0; i < 32; ++i) scr[(2 * i + (lane >> 5)) * 33 + (lane & 31)] = tmp[i];
    LDS_WAIT();
    const int c = lane & 7;
#pragma unroll
    for (int j = 0; j < 4; ++j) { const int n = (lane >> 3) + 8 * j; const LAS float* s = scr + (8 * c) * 33 + n;
        u32x4 o; o.x = pk2(s[0 * 33], s[1 * 33]); o.y = pk2(s[2 * 33], s[3 * 33]); o.z = pk2(s[4 * 33], s[5 * 33]); o.w = pk2(s[6 * 33], s[7 * 33]);
        *(u32x4*)(WT + (size_t)(drow0 + n) * ldt + k0 + 8 * c) = o; }
    LDS_WAIT();
}
__device__ __forceinline__ int swiglu_row(int n0) {
    return n0 < DFF ? 256 * (n0 / 128) + (n0 % 128) : 256 * ((n0 - DFF) / 128) + 128 + ((n0 - DFF) % 128);
}
__device__ __forceinline__ void phase_prep(const Params& p, LAS unsigned char* lds, int wave, int lane) {
    LAS float* scr = (LAS float*)(lds + wave * 16384);
    const int gw = blockIdx.x * 8 + wave, NGW = gridDim.x * 8;
    constexpr int I_IN = (DM / 64) * (2 * DFF / 32), I_OUT = (DFF / 64) * (DM / 32), I_3 = (DM / 64) * (INW / 32), I_4 = (DM / 64) * (DM / 32), I_G = 32 * 2, I_P = 4 * 2 * 4;
    constexpr int NITEMS = 2 * I_IN + 2 * I_OUT + I_3 + I_4 + I_G + I_P;
    for (int it = gw; it < NITEMS; it += NGW) {
        int r = it;
        if (r < 2 * I_IN) { const bool second = r >= I_IN; if (second) r -= I_IN; const int nblk = 2 * DFF / 32, kb = r / nblk, nb = r % nblk;
            tr_item(second ? p.f2_win : p.f1_win, 2 * DFF, 64 * kb, 32 * nb, second ? p.W5 : p.W1, DM, swiglu_row(32 * nb), scr, lane); continue; }
        r -= 2 * I_IN;
        if (r < 2 * I_OUT) { const bool second = r >= I_OUT; if (second) r -= I_OUT; const int nblk = DM / 32, kb = r / nblk, nb = r % nblk;
            tr_item(second ? p.f2_wout : p.f1_wout, DM, 64 * kb, 32 * nb, second ? p.W6 : p.W2, DFF, 32 * nb, scr, lane); continue; }
        r -= 2 * I_OUT;
        if (r < I_3) { const int nblk = INW / 32, kb = r / nblk, nb = r % nblk; tr_item(p.w_in, INW, 64 * kb, 32 * nb, p.W3, DM, 32 * nb, scr, lane); continue; }
        r -= I_3;
        if (r < I_4) { const int nblk = DM / 32, kb = r / nblk, nb = r % nblk; tr_item(p.w_out, DM, 64 * kb, 32 * nb, p.W4, DM, 32 * nb, scr, lane); continue; }
        r -= I_4;
        if (r < I_G) { const int mat = r >> 5, mi = (r >> 1) & 15, nb = r & 1;
            tr_item((mat ? p.w_x : p.w_a) + (size_t)mi * 4096, 64, 0, 32 * nb, p.WG + (size_t)(mat * 16 + mi) * 4096, 64, 32 * nb, scr, lane); continue; }
        r -= I_G;
        { const int g = r >> 3, kb = (r >> 2) & 1, nb = r & 3; tr_item(p.pool_w + (size_t)g * 16384, 128, 64 * kb, 32 * nb, p.WP + (size_t)g * 16384, 128, 32 * nb, scr, lane); }
    }
    if (blockIdx.x == 0) { for (int i = threadIdx.x; i < 2 * LRW; i += 512) p.C8[i] = -8.0f * 1.4426950408889634f * log1pf(expf(-p.lam[i])); }
    f32x4 gv[4];
#pragma unroll
    for (int j = 0; j < 4; ++j) gv[j] = *(const f32x4*)(p.f1_pre + j * 256 + lane * 4);
    for (int r = gw; r < T_ROWS; r += NGW) {
        const float* xr = r < TP_ROWS ? p.xp + (size_t)r * DM : p.xs + (size_t)(r - TP_ROWS) * DM;
        f32x4 v[4]; float ss = 0.f;
#pragma unroll
        for (int j = 0; j < 4; ++j) { v[j] = *(const f32x4*)(xr + j * 256 + lane * 4); ss += (v[j][0] * v[j][0] + v[j][1] * v[j][1]) + (v[j][2] * v[j][2] + v[j][3] * v[j][3]); }
        const float sc = rsqrtf(wave_sum(ss) * (1.0f / DM) + EPS);
        bf16_t* o = p.XN + (size_t)r * DM;
#pragma unroll
        for (int j = 0; j < 4; ++j) { u32x2 w; w.x = pk2(v[j][0] * sc * gv[j][0], v[j][1] * sc * gv[j][1]); w.y = pk2(v[j][2] * sc * gv[j][2], v[j][3] * sc * gv[j][3]); *(u32x2*)(o + j * 256 + lane * 4) = w; }
    }
}

template <int MODE>
__device__ __forceinline__ void phase_rows(const Params& p, int wave, int lane) {
    const int gw = blockIdx.x * 8 + wave, NGW = gridDim.x * 8;
    const float* gpost = MODE == 0 ? p.f1_post : (MODE == 1 ? p.mx_post : p.f2_post);
    const float* gnext = MODE == 0 ? p.mx_pre : p.f2_pre;
    const float alpha = MODE == 1 ? 1.0f : 0.5f;
    f32x4 gp[4], gn[4];
#pragma unroll
    for (int j = 0; j < 4; ++j) { gp[j] = *(const f32x4*)(gpost + j * 256 + lane * 4); if (MODE != 2) gn[j] = *(const f32x4*)(gnext + j * 256 + lane * 4); }
    for (int rb = gw; rb < T_ROWS; rb += 2 * NGW) {
        int rr[2]; rr[0] = rb; rr[1] = rb + NGW < T_ROWS ? rb + NGW : rb;
        f32x4 x[2][4], y[2][4];
#pragma unroll
        for (int q = 0; q < 2; ++q) {
            const int r = rr[q];
            const bf16_t* yr = (MODE == 1 ? p.O : p.XN) + (size_t)r * DM;
#pragma unroll
            for (int j = 0; j < 4; ++j) {
                if (MODE == 0) { const float* xr = r < TP_ROWS ? p.xp + (size_t)r * DM : p.xs + (size_t)(r - TP_ROWS) * DM; x[q][j] = *(const f32x4*)(xr + j * 256 + lane * 4); }
                else { const u32x2 w = *(const u32x2*)(p.XR + (size_t)r * DM + j * 256 + lane * 4); x[q][j] = (f32x4){bflo(w.x), bfhi(w.x), bflo(w.y), bfhi(w.y)}; }
                const u32x2 w = *(const u32x2*)(yr + j * 256 + lane * 4);
                y[q][j] = (f32x4){bflo(w.x), bfhi(w.x), bflo(w.y), bfhi(w.y)};
            }
        }
        float ss[2] = {0.f, 0.f};
#pragma unroll
        for (int q = 0; q < 2; ++q)
#pragma unroll
            for (int j = 0; j < 4; ++j) ss[q] += (y[q][j][0] * y[q][j][0] + y[q][j][1] * y[q][j][1]) + (y[q][j][2] * y[q][j][2] + y[q][j][3] * y[q][j][3]);
#pragma unroll
        for (int o = 1; o < 64; o <<= 1) { ss[0] += __shfl_xor(ss[0], o); ss[1] += __shfl_xor(ss[1], o); }
        float s2[2] = {0.f, 0.f};
#pragma unroll
        for (int q = 0; q < 2; ++q) {
            const int r = rr[q];
            const float sc = rsqrtf(ss[q] * (1.0f / DM) + EPS) * alpha;
#pragma unroll
            for (int j = 0; j < 4; ++j) {
#pragma unroll
                for (int e = 0; e < 4; ++e) x[q][j][e] += y[q][j][e] * sc * gp[j][e];
                if (MODE == 2) __builtin_nontemporal_store(x[q][j], (f32x4*)(p.out + (size_t)r * DM + j * 256 + lane * 4));
                else {
                    u32x2 w; w.x = pk2(x[q][j][0], x[q][j][1]); w.y = pk2(x[q][j][2], x[q][j][3]); __builtin_nontemporal_store(w, (u32x2*)(p.XR + (size_t)r * DM + j * 256 + lane * 4));
                    x[q][j] = (f32x4){bflo(w.x), bfhi(w.x), bflo(w.y), bfhi(w.y)};
#pragma unroll
                    for (int e = 0; e < 4; ++e) s2[q] += x[q][j][e] * x[q][j][e];
                }
            }
        }
        if (MODE != 2) {
#pragma unroll
            for (int o = 1; o < 64; o <<= 1) { s2[0] += __shfl_xor(s2[0], o); s2[1] += __shfl_xor(s2[1], o); }
#pragma unroll
            for (int q = 0; q < 2; ++q) {
                const float sn = rsqrtf(s2[q] * (1.0f / DM) + EPS);
                bf16_t* o = p.XN + (size_t)rr[q] * DM;
#pragma unroll
                for (int j = 0; j < 4; ++j) { u32x2 w; w.x = pk2(x[q][j][0] * sn * gn[j][0], x[q][j][1] * sn * gn[j][1]); w.y = pk2(x[q][j][2] * sn * gn[j][2], x[q][j][3] * sn * gn[j][3]); *(u32x2*)(o + j * 256 + lane * 4) = w; }
            }
        }
    }
}

__device__ __forceinline__ f32x4 mfma16(bf16x8 a, bf16x8 b, f32x4 c) { return __builtin_amdgcn_mfma_f32_16x16x32_bf16(a, b, c, 0, 0, 0); }

__device__ __forceinline__ void gate_prefetch(const Params& p, size_t row0, int wave, int lane, int i0, u32x4 (&gb)[4]) {
#pragma unroll
    for (int i = 0; i < 4; ++i) gb[i] = *(const u32x4*)(p.Z + (row0 + wave * 8 + i0 + i) * INW + LRW + lane * 8);
}
template <bool GATE>
__device__ __forceinline__ void finalize_rows(const Params& p, const LAS float* img, size_t row0, const float* gain, int coloff, int wave, int lane, u32x4 (&gb)[4]) {
    const int c = lane * 8;
    const f32x4 g0 = *(const f32x4*)(gain + c), g1 = *(const f32x4*)(gain + c + 4);
#pragma unroll
    for (int i0 = 0; i0 < 8; i0 += 4) {
        f32x4 s0[4], s1[4]; float ss[4];
        u32x4 gc[4];
#pragma unroll
        for (int i = 0; i < 4; ++i) gc[i] = gb[i];
        if (GATE && i0 == 0) gate_prefetch(p, row0, wave, lane, 4, gb);
#pragma unroll
        for (int i = 0; i < 4; ++i) { const int tl = wave * 8 + i0 + i; s0[i] = *(const LAS f32x4*)(img + tl * LDS_ROW + c); s1[i] = *(const LAS f32x4*)(img + tl * LDS_ROW + c + 4); }
#pragma unroll
        for (int i = 0; i < 4; ++i) {
            if (GATE) {
                const u32x4 g = gc[i];
                const f32x2 a0 = gelu_mul2(bf2(g.x), (f32x2){s0[i][0], s0[i][1]}), a1 = gelu_mul2(bf2(g.y), (f32x2){s0[i][2], s0[i][3]});
                const f32x2 a2 = gelu_mul2(bf2(g.z), (f32x2){s1[i][0], s1[i][1]}), a3 = gelu_mul2(bf2(g.w), (f32x2){s1[i][2], s1[i][3]});
                s0[i] = (f32x4){a0.x, a0.y, a1.x, a1.y}; s1[i] = (f32x4){a2.x, a2.y, a3.x, a3.y};
            }
            ss[i] = (s0[i][0] * s0[i][0] + s0[i][1] * s0[i][1]) + (s0[i][2] * s0[i][2] + s0[i][3] * s0[i][3]) + (s1[i][0] * s1[i][0] + s1[i][1] * s1[i][1]) + (s1[i][2] * s1[i][2] + s1[i][3] * s1[i][3]);
        }
#pragma unroll
        for (int o = 1; o < 64; o <<= 1) {
#pragma unroll
            for (int i = 0; i < 4; ++i) ss[i] += __shfl_xor(ss[i], o);
        }
#pragma unroll
        for (int i = 0; i < 4; ++i) {
            const float sc = rsqrtf(ss[i] * (1.0f / LRW) + EPS);
            u32x4 w; w.x = pk2(s0[i][0] * sc * g0[0], s0[i][1] * sc * g0[1]); w.y = pk2(s0[i][2] * sc * g0[2], s0[i][3] * sc * g0[3]);
            w.z = pk2(s1[i][0] * sc * g1[0], s1[i][1] * sc * g1[1]); w.w = pk2(s1[i][2] * sc * g1[2], s1[i][3] * sc * g1[3]);
            *(u32x4*)(p.XN + (row0 + wave * 8 + i0 + i) * DM + coloff + c) = w;
        }
    }
}

struct GateSet { bf16x8 Ba[2], Bx[2]; float ba, bx, c8, car; };
template <bool FINAL>
__device__ __forceinline__ void gate_load(const Params& p, GateSet& G, int head, int cb, int dir, int fr, int fq, int seq, int chunk) {
    const int chl = head * 64 + cb * 16 + fr;
    const bf16_t* wa = p.WG + (size_t)((0 * 2 + dir) * 8 + head) * 4096 + (cb * 16 + fr) * 64 + fq * 8;
    const bf16_t* wx = p.WG + (size_t)((1 * 2 + dir) * 8 + head) * 4096 + (cb * 16 + fr) * 64 + fq * 8;
    G.Ba[0] = *(const bf16x8*)wa; G.Ba[1] = *(const bf16x8*)(wa + 32); G.Bx[0] = *(const bf16x8*)wx; G.Bx[1] = *(const bf16x8*)(wx + 32);
    G.ba = p.b_a[dir * LRW + chl]; G.bx = p.b_x[dir * LRW + chl]; G.c8 = p.C8[dir * LRW + chl];
    if (FINAL) G.car = p.CAR[((size_t)(dir * NSEQ + seq) * NCHUNK + chunk) * LRW + chl]; else G.car = 0.f;
}

#ifndef PF_KK
#define PF_KK 1
#endif
__device__ __forceinline__ void raw_issue(const Params& p, u32x4 (&raw)[2][4], int item, int kk, int tp, int head, int fr, int fq) {
    const int seq = item >> 6, pos0 = (item & 63) * 64;
    const bf16_t* Zr = p.Z + (size_t)seq * SEQ * INW + head * 64 + kk * 32 + fq * 8;
#pragma unroll
    for (int t2 = 0; t2 < 2; ++t2)
#pragma unroll
        for (int k = 0; k < 4; ++k) { const int pp = pos0 + (fr >> 2) * 16 + (tp * 2 + t2) * 4 + (fr & 3) + k - 2, pc = min(max(pp, 0), SEQ - 1); raw[t2][k] = *(const u32x4*)(Zr + (size_t)pc * INW); }
}
template <bool FINAL>
__device__ __forceinline__ void scan_phase(const Params& p, LAS float* img, int wave, int lane) {
  const int head = wave, fr = lane & 15, fq = lane >> 4;
  u32x4 raw0[2][4];
  int item = blockIdx.x;
  if (!FINAL && item < NSEQ * NCHUNK) raw_issue(p, raw0, item, 0, 0, head, fr, fq);
  for (; item < NSEQ * NCHUNK; item += gridDim.x) {
    const int seq = item >> 6, chunk = item & 63;
    const size_t srow0 = (size_t)seq * SEQ, row0 = srow0 + (size_t)chunk * 64;
    const int pos0 = chunk * 64;
    GateSet nxt;
    gate_load<FINAL>(p, nxt, head, 0, 0, fr, fq, seq, chunk);
    bf16x8 Af[4][2];
    u32x4* xa = p.XA + ((size_t)item * 8 + head) * 8 * 64 + lane;
    if (FINAL) {
#pragma unroll
        for (int tb = 0; tb < 4; ++tb)
#pragma unroll
            for (int kk = 0; kk < 2; ++kk) Af[tb][kk] = __builtin_bit_cast(bf16x8, xa[(tb * 2 + kk) * 64]);
    } else {
    u32x4 rB[2][4];
    raw_issue(p, rB, item, 0, 1, head, fr, fq);
#pragma unroll
    for (int kk = 0; kk < 2; ++kk) {
        const int c0 = head * 64 + kk * 32 + fq * 8;
        f32x2 w[4][4], b[4];
#pragma unroll
        for (int k = 0; k < 4; ++k) { const f32x4 a0 = *(const f32x4*)(p.conv_w + k * LRW + c0), a1 = *(const f32x4*)(p.conv_w + k * LRW + c0 + 4);
            w[k][0] = (f32x2){a0[0], a0[1]}; w[k][1] = (f32x2){a0[2], a0[3]}; w[k][2] = (f32x2){a1[0], a1[1]}; w[k][3] = (f32x2){a1[2], a1[3]}; }
        { const f32x4 a0 = *(const f32x4*)(p.conv_b + c0), a1 = *(const f32x4*)(p.conv_b + c0 + 4);
            b[0] = (f32x2){a0[0], a0[1]}; b[1] = (f32x2){a0[2], a0[3]}; b[2] = (f32x2){a1[0], a1[1]}; b[3] = (f32x2){a1[2], a1[3]}; }
#pragma unroll
        for (int tp = 0; tp < 2; ++tp) {
            u32x4 cur[2][4];
#pragma unroll
            for (int t2 = 0; t2 < 2; ++t2)
#pragma unroll
                for (int k = 0; k < 4; ++k) cur[t2][k] = (tp == 0) ? raw0[t2][k] : rB[t2][k];
            if (kk == 0 && tp == 0) raw_issue(p, raw0, item, 1, 0, head, fr, fq);
            if (kk == 0 && tp == 1) raw_issue(p, rB, item, 1, 1, head, fr, fq);
#pragma unroll
            for (int t2 = 0; t2 < 2; ++t2) {
                const int tb = tp * 2 + t2;
                f32x2 xc[4];
#pragma unroll
                for (int e = 0; e < 4; ++e) xc[e] = b[e];
#pragma unroll
                for (int k = 0; k < 4; ++k) {
                    const int pp = pos0 + (fr >> 2) * 16 + tb * 4 + (fr & 3) + k - 2;
                    u32x4 v = cur[t2][k];
                    if (pp < 0 || pp >= SEQ) v = (u32x4){0u, 0u, 0u, 0u};
                    xc[0] += bf2(v.x) * w[k][0]; xc[1] += bf2(v.y) * w[k][1]; xc[2] += bf2(v.z) * w[k][2]; xc[3] += bf2(v.w) * w[k][3];
                }
                u32x4 pk; pk.x = pk2(xc[0].x, xc[0].y); pk.y = pk2(xc[1].x, xc[1].y); pk.z = pk2(xc[2].x, xc[2].y); pk.w = pk2(xc[3].x, xc[3].y);
                Af[tb][kk] = __builtin_bit_cast(bf16x8, pk);
            }
            __builtin_amdgcn_sched_barrier(0);
        }
    }
#pragma unroll
    for (int tb = 0; tb < 4; ++tb)
#pragma unroll
        for (int kk = 0; kk < 2; ++kk) xa[(tb * 2 + kk) * 64] = __builtin_bit_cast(u32x4, Af[tb][kk]);
    if (item + (int)gridDim.x < NSEQ * NCHUNK) raw_issue(p, raw0, item + gridDim.x, 0, 0, head, fr, fq);
    }
#pragma unroll 1
    for (int cb = 0; cb < 4; ++cb) {
        const int chl = head * 64 + cb * 16 + fr;
        f32x4 xcD[4];
        {
            bf16x8 Id[2];
#pragma unroll
            for (int kk = 0; kk < 2; ++kk)
#pragma unroll
                for (int j = 0; j < 8; ++j) Id[kk][j] = (kk * 32 + fq * 8 + j == cb * 16 + fr) ? (short)0x3F80 : (short)0;
#pragma unroll
            for (int tb = 0; tb < 4; ++tb) { xcD[tb] = (f32x4){0.f, 0.f, 0.f, 0.f}; xcD[tb] = mfma16(Af[tb][0], Id[0], xcD[tb]); xcD[tb] = mfma16(Af[tb][1], Id[1], xcD[tb]); }
        }
        float hs[16];
#pragma unroll
        for (int dir = 0; dir < 2; ++dir) {
            const GateSet G = nxt;
            if (dir == 0) gate_load<FINAL>(p, nxt, head, cb, 1, fr, fq, seq, chunk); else gate_load<FINAL>(p, nxt, head, cb < 3 ? cb + 1 : 3, 0, fr, fq, seq, chunk);
            const float nba = -1.4426950408889634f * G.ba, nbx = -1.4426950408889634f * G.bx, c8 = G.c8;
            float a[16], u[16];
#pragma unroll
            for (int tb = 0; tb < 4; ++tb) {
                f32x4 ra = (f32x4){0.f, 0.f, 0.f, 0.f}, rx = (f32x4){0.f, 0.f, 0.f, 0.f};
                ra = mfma16(Af[tb][0], G.Ba[0], ra); ra = mfma16(Af[tb][1], G.Ba[1], ra);
                rx = mfma16(Af[tb][0], G.Bx[0], rx); rx = mfma16(Af[tb][1], G.Bx[1], rx);
#pragma unroll
                for (int jp = 0; jp < 2; ++jp) {
                    f32x2 ea = (f32x2){ra[2 * jp], ra[2 * jp + 1]} * (-1.4426950408889634f) + nba;
                    f32x2 ex = (f32x2){rx[2 * jp], rx[2 * jp + 1]} * (-1.4426950408889634f) + nbx;
                    ea = (f32x2){__builtin_amdgcn_exp2f(ea.x), __builtin_amdgcn_exp2f(ea.y)}; ex = (f32x2){__builtin_amdgcn_exp2f(ex.x), __builtin_amdgcn_exp2f(ex.y)};
                    ea = ea + 1.0f; ex = ex + 1.0f;
                    const f32x2 r = (f32x2){__builtin_amdgcn_rcpf(ea.x), __builtin_amdgcn_rcpf(ea.y)}, ig = (f32x2){__builtin_amdgcn_rcpf(ex.x), __builtin_amdgcn_rcpf(ex.y)};
                    const f32x2 la = r * c8;
                    const f32x2 av = (f32x2){__builtin_amdgcn_exp2f(la.x), __builtin_amdgcn_exp2f(la.y)};
                    const f32x2 om = 1.0f - av * av;
                    const f32x2 sq = (f32x2){__builtin_amdgcn_sqrtf(om.x), __builtin_amdgcn_sqrtf(om.y)};
                    const f32x2 uu = sq * (ig * (f32x2){xcD[tb][2 * jp], xcD[tb][2 * jp + 1]});
                    a[tb * 4 + 2 * jp] = av.x; a[tb * 4 + 2 * jp + 1] = av.y; u[tb * 4 + 2 * jp] = uu.x; u[tb * 4 + 2 * jp + 1] = uu.y;
                }
            }
            float P = 1.0f, E = 0.0f;
            if (dir == 0) {
#pragma unroll
                for (int t = 0; t < 16; ++t) { E = a[t] * E + u[t]; P *= a[t]; }
            } else {
#pragma unroll
                for (int t = 15; t >= 0; --t) { E = a[t] * E + u[t]; P *= a[t]; }
            }
            float Pq[4], Eq[4];
#pragma unroll
            for (int q = 0; q < 4; ++q) { Pq[q] = __shfl(P, q * 16 + fr); Eq[q] = __shfl(E, q * 16 + fr); }
            if (!FINAL) {
                float run = 0.f, pt = 1.f;
                if (dir == 0) {
#pragma unroll
                    for (int q = 0; q < 4; ++q) { run = Eq[q] + Pq[q] * run; pt *= Pq[q]; }
                } else {
#pragma unroll
                    for (int q = 3; q >= 0; --q) { run = Eq[q] + Pq[q] * run; pt *= Pq[q]; }
                }
                if (fq == 0) p.AGG[((size_t)(dir * NSEQ + seq) * NCHUNK + chunk) * LRW + chl] = (f32x2){pt, run};
            } else {
                float run = G.car;
                if (dir == 0) {
#pragma unroll
                    for (int q = 0; q < 4; ++q) if (q < fq) run = Eq[q] + Pq[q] * run;
                    float h = run;
#pragma unroll
                    for (int t = 0; t < 16; ++t) { h = a[t] * h + u[t]; hs[t] = h; }
                } else {
#pragma unroll
                    for (int q = 3; q >= 0; --q) if (q > fq) run = Eq[q] + Pq[q] * run;
                    float h = run;
#pragma unroll
                    for (int t = 15; t >= 0; --t) { h = a[t] * h + u[t]; hs[t] += h; }
                }
            }
        }
        if (FINAL) {
#pragma unroll
            for (int t = 0; t < 16; ++t) img[(fq * 16 + t) * LDS_ROW + chl] = hs[t];
        }
    }
    if (FINAL) {
        u32x4 gb[4];
        gate_prefetch(p, row0, wave, lane, 0, gb);
        lds_barrier();
        finalize_rows<true>(p, img, row0, p.lru_g, 0, wave, lane, gb);
        lds_barrier();
    }
  }
}

constexpr int POOL_ZROW = 48;
__device__ __forceinline__ void pool_phase(const Params& p, LAS float* img, int wave, int lane) {
    for (int i = threadIdx.x; i < LDS_ROW; i += 512) img[POOL_ZROW * LDS_ROW + i] = 0.f;
    const int g = wave >> 1, nh = wave & 1, fr = lane & 15, fq = lane >> 4;
    const bf16_t* Z = p.Z;
    bf16x8 Bf[4][4]; float psc[4];
#pragma unroll
    for (int kk = 0; kk < 4; ++kk)
#pragma unroll
        for (int nb = 0; nb < 4; ++nb) Bf[kk][nb] = *(const bf16x8*)(p.WP + (size_t)g * 16384 + (nh * 64 + nb * 16 + fr) * 128 + kk * 32 + fq * 8);
#pragma unroll
    for (int nb = 0; nb < 4; ++nb) psc[nb] = p.pool_scale[g * 128 + nh * 64 + nb * 16 + fr];
    const int c = lane * 8, half = 1 << (lane >> 4);
    const f32x4 g0 = *(const f32x4*)(p.pool_g + c), g1 = *(const f32x4*)(p.pool_g + c + 4);
#define POOL_ISSUE(dst, it_) do { const int seq_ = (it_) >> 7, p0_ = ((it_) & 127) * 32; _Pragma("unroll") for (int tb = 0; tb < 3; ++tb) { \
        const int pc_ = min(max(p0_ - 8 + tb * 16 + fr, 0), SEQ - 1); const bf16_t* zr_ = Z + ((size_t)seq_ * SEQ + pc_) * INW + 2 * LRW + g * 128 + fq * 8; \
        _Pragma("unroll") for (int kk = 0; kk < 4; ++kk) dst[tb][kk] = *(const u32x4*)(zr_ + kk * 32); } } while (0)
    u32x4 vn[3][4];
    if ((int)blockIdx.x < NSEQ * (SEQ / 32)) POOL_ISSUE(vn, (int)blockIdx.x);
    for (int item = blockIdx.x; item < NSEQ * (SEQ / 32); item += gridDim.x) {
        const int seq = item >> 7, pos0 = (item & 127) * 32;
        const size_t srow0 = (size_t)seq * SEQ;
        u32x4 v[3][4];
#pragma unroll
        for (int tb = 0; tb < 3; ++tb) {
            const int pp = pos0 - 8 + tb * 16 + fr;
#pragma unroll
            for (int kk = 0; kk < 4; ++kk) { v[tb][kk] = vn[tb][kk]; if (pp < 0 || pp >= SEQ) v[tb][kk] = (u32x4){0u, 0u, 0u, 0u}; }
        }
        if (item + (int)gridDim.x < NSEQ * (SEQ / 32)) POOL_ISSUE(vn, item + (int)gridDim.x);
#pragma unroll
        for (int tb = 0; tb < 3; ++tb) {
            f32x4 acc[4];
#pragma unroll
            for (int nb = 0; nb < 4; ++nb) acc[nb] = (f32x4){0.f, 0.f, 0.f, 0.f};
#pragma unroll
            for (int kk = 0; kk < 4; ++kk) { const bf16x8 Afr = __builtin_bit_cast(bf16x8, v[tb][kk]);
#pragma unroll
                for (int nb = 0; nb < 4; ++nb) acc[nb] = mfma16(Afr, Bf[kk][nb], acc[nb]); }
#pragma unroll
            for (int nb = 0; nb < 4; ++nb)
#pragma unroll
                for (int j = 0; j < 4; ++j) img[(tb * 16 + fq * 4 + j) * LDS_ROW + g * 128 + nh * 64 + nb * 16 + fr] = acc[nb][j] * psc[nb];
        }
        lds_barrier();
        f32x4 d0[4], d1[4]; float ss[4];
        {
            const int row0 = wave * 4 + 8;
            f32x4 s0 = (f32x4){0.f, 0.f, 0.f, 0.f}, s1 = s0;
#pragma unroll
            for (int d = -8; d < 8; ++d) {
                const int r = (d >= -half && d < half) ? row0 + d : POOL_ZROW;
                s0 += *(const LAS f32x4*)(img + r * LDS_ROW + c); s1 += *(const LAS f32x4*)(img + r * LDS_ROW + c + 4);
            }
#pragma unroll
            for (int i = 0; i < 4; ++i) {
                const int row = row0 + i, pos = pos0 + wave * 4 + i;
                if (i > 0) {
                    s0 += *(const LAS f32x4*)(img + (row - 1 + half) * LDS_ROW + c) - *(const LAS f32x4*)(img + (row - 1 - half) * LDS_ROW + c);
                    s1 += *(const LAS f32x4*)(img + (row - 1 + half) * LDS_ROW + c + 4) - *(const LAS f32x4*)(img + (row - 1 - half) * LDS_ROW + c + 4);
                }
                const int lo = max(pos - half, 0), hi = min(pos + half, SEQ);
                const float inv = 1.0f / (float)(hi - lo);
                d0[i] = s0 * inv - *(const LAS f32x4*)(img + row * LDS_ROW + c); d1[i] = s1 * inv - *(const LAS f32x4*)(img + row * LDS_ROW + c + 4);
                ss[i] = (d0[i][0] * d0[i][0] + d0[i][1] * d0[i][1]) + (d0[i][2] * d0[i][2] + d0[i][3] * d0[i][3]) + (d1[i][0] * d1[i][0] + d1[i][1] * d1[i][1]) + (d1[i][2] * d1[i][2] + d1[i][3] * d1[i][3]);
            }
        }
#pragma unroll
        for (int o = 1; o < 64; o <<= 1) {
#pragma unroll
            for (int i = 0; i < 4; ++i) ss[i] += __shfl_xor(ss[i], o);
        }
#pragma unroll
        for (int i = 0; i < 4; ++i) {
            const float sc = rsqrtf(ss[i] * (1.0f / LRW) + EPS);
            u32x4 w; w.x = pk2(d0[i][0] * sc * g0[0], d0[i][1] * sc * g0[1]); w.y = pk2(d0[i][2] * sc * g0[2], d0[i][3] * sc * g0[3]);
            w.z = pk2(d1[i][0] * sc * g1[0], d1[i][1] * sc * g1[1]); w.w = pk2(d1[i][2] * sc * g1[2], d1[i][3] * sc * g1[3]);
            *(u32x4*)(p.XN + (srow0 + pos0 + wave * 4 + i) * DM + LRW + c) = w;
        }
        lds_barrier();
    }
}

__device__ __forceinline__ void phase_carries(const Params& p) {
    for (int id = blockIdx.x * 512 + threadIdx.x; id < 2 * NSEQ * LRW; id += gridDim.x * 512) {
        const int dir = id / (NSEQ * LRW), rem = id % (NSEQ * LRW), seq = rem / LRW, ch = rem % LRW;
        const size_t base = (size_t)(dir * NSEQ + seq) * NCHUNK * LRW + ch;
        float run = 0.f;
#pragma unroll 1
        for (int c0 = 0; c0 < NCHUNK; c0 += 16) {
            f32x2 pe[16];
#pragma unroll
            for (int i = 0; i < 16; ++i) { const int c = dir == 0 ? c0 + i : NCHUNK - 1 - c0 - i; pe[i] = p.AGG[base + (size_t)c * LRW]; }
#pragma unroll
            for (int i = 0; i < 16; ++i) { const int c = dir == 0 ? c0 + i : NCHUNK - 1 - c0 - i; p.CAR[base + (size_t)c * LRW] = run; run = pe[i].y + pe[i].x * run; }
        }
    }
}

#define XB_TMO      128
#define XB_XCNT(j)  (256  + 64 * (j))
#define XB_XSUB(j)  (1280 + 64 * (j))
#define XB_XGEN(j)  (2304 + 64 * (j))
#define XB_TOP      3328
#define XB_TOPGEN   3392
#define XCD_BAR_WORDS 3456
#define XB_SPIN_CAP (1u << 18)
__device__ __forceinline__ unsigned xb_ld(unsigned* p)              { return __hip_atomic_load(p, __ATOMIC_RELAXED, __HIP_MEMORY_SCOPE_AGENT); }
__device__ __forceinline__ unsigned xb_add(unsigned* p, unsigned v) { return __hip_atomic_fetch_add(p, v, __ATOMIC_RELAXED, __HIP_MEMORY_SCOPE_AGENT); }
__device__ __forceinline__ unsigned xb_xcc_id() { return (unsigned)__builtin_amdgcn_s_getreg((3 << 11) | 20) & 0xFu; }
#define XB_SPIN(cond, bar) do { unsigned _sp = 0; while (cond) { __builtin_amdgcn_s_sleep(1); \
    if ((++_sp & 255u) == 0u) { if (xb_ld(&(bar)[XB_TMO])) break; if (_sp > XB_SPIN_CAP) { atomicAdd(&(bar)[XB_TMO], 1u); break; } } } } while (0)
struct XcdBarrier { unsigned* bar; unsigned x; volatile LAS unsigned* st; };
__device__ __forceinline__ XcdBarrier xcd_barrier_post(unsigned* bar, volatile LAS unsigned* st) {
    XcdBarrier b; b.bar = bar; b.x = xb_xcc_id(); b.st = st;
    if (threadIdx.x == 0) (void)xb_add(&bar[XB_XCNT(b.x)], 1u);
    return b;
}
__device__ __forceinline__ void xcd_barrier_complete(unsigned* bar, unsigned x, unsigned& nloc, unsigned& nx) {
    const unsigned G = gridDim.x * gridDim.y * gridDim.z;
    unsigned sum, cnt, mine, sp = 0u;
    for (;;) {
        sum = 0u; cnt = 0u; mine = 0u;
#pragma unroll
        for (unsigned j = 0; j < 16; ++j) { const unsigned c = xb_ld(&bar[XB_XCNT(j)]); sum += c; cnt += (c > 0u) ? 1u : 0u; mine = (j == x) ? c : mine; }
        if (sum == G) break;
        __builtin_amdgcn_s_sleep(1);
        if ((++sp & 255u) == 0u) { if (xb_ld(&bar[XB_TMO])) break; if (sp > XB_SPIN_CAP) { atomicAdd(&bar[XB_TMO], 1u); break; } }
    }
    nloc = mine > 0u ? mine : 1u; nx = cnt > 0u ? cnt : 1u;
}
__device__ __forceinline__ void xcd_barrier(const XcdBarrier& b) {
    asm volatile("s_waitcnt vmcnt(0)" ::: "memory");
    __syncthreads();
    if (threadIdx.x == 0) {
        unsigned* bar = b.bar;
        __builtin_amdgcn_s_waitcnt(0);
        unsigned nloc = b.st[0], nx = b.st[1];
        if (nloc == 0u) { xcd_barrier_complete(bar, b.x, nloc, nx); b.st[0] = nloc; b.st[1] = nx; }
        const unsigned old = xb_add(&bar[XB_XSUB(b.x)], 1u);
        const unsigned gen = old / nloc;
        if (old + 1u == (gen + 1u) * nloc) {
            __builtin_amdgcn_fence(__ATOMIC_RELEASE, "agent");
            asm volatile("s_waitcnt vmcnt(0)" ::: "memory");
            const unsigned og = xb_add(&bar[XB_TOP], 1u);
            const unsigned tg = og / nx;
            if (og + 1u == (tg + 1u) * nx) xb_add(&bar[XB_TOPGEN], 1u);
            else XB_SPIN(xb_ld(&bar[XB_TOPGEN]) == tg, bar);
            __builtin_amdgcn_fence(__ATOMIC_ACQUIRE, "agent");
            xb_add(&bar[XB_XGEN(b.x)], 1u);
            asm volatile("s_waitcnt vmcnt(0)" ::: "memory");
        } else {
            XB_SPIN(xb_ld(&bar[XB_XGEN(b.x)]) == gen, bar);
            __builtin_amdgcn_fence(__ATOMIC_ACQUIRE, "agent");
            asm volatile("s_waitcnt vmcnt(0)" ::: "memory");
        }
    }
    __syncthreads();
}

constexpr int N_PHASES = 13;
template <class Epi>
__device__ __forceinline__ void run_gemm(LAS unsigned char* lds, const bf16_t* A, const bf16_t* Bt, int N, int K, const Epi& E) {
    pg8::Gemm g{A, Bt, T_ROWS, N, K};
    pg8::StaticOrder S; S.init(g.M, g.N, (int)gridDim.x, (int)blockIdx.x);
    pg8::gemm_phase(lds, g, S, E);
}
template <bool COOP>
__global__ __launch_bounds__(512, 2) void mk_fwd(Params p, int ph_lo, int ph_hi) {
    extern __shared__ __attribute__((aligned(16))) unsigned char shm[];
    LAS unsigned char* lds = (LAS unsigned char*)shm;
    XcdBarrier xb{};
    if (COOP) {
        volatile LAS unsigned* st = (volatile LAS unsigned*)(lds + LDS_BYTES);
        if (threadIdx.x == 0) { st[0] = 0u; st[1] = 0u; }
        __syncthreads();
        xb = xcd_barrier_post(p.BAR, st);
        if (ph_hi > N_PHASES) cg::this_grid().sync();
    }
#define MK_ON(k) (ph_lo <= (k) && (k) < ph_hi)
#define MK_SYNC(k) do { if (COOP) { if (ph_lo <= (k) && (k) + 1 < ph_hi) xcd_barrier(xb); } } while (0)
#define MK_WL const int tid_ = opaque_tid(), wave = __builtin_amdgcn_readfirstlane(tid_ >> 6), lane = tid_ & 63
    if ((MK_MASK & 4) && MK_ON(0)) { MK_WL; phase_prep(p, lds, wave, lane); }
    MK_SYNC(0);
    if ((MK_MASK & 1) && MK_ON(1)) run_gemm(lds, p.XN, p.W1, 2 * DFF, DM, pg8::EpiSwiGLU{p.H});
    MK_SYNC(1);
    if ((MK_MASK & 2) && MK_ON(2)) run_gemm(lds, p.H, p.W2, DM, DFF, pg8::EpiBf16{p.XN, DM});
    MK_SYNC(2);
    if ((MK_MASK & 8) && MK_ON(3)) { MK_WL; phase_rows<0>(p, wave, lane); }
    MK_SYNC(3);
    if ((MK_MASK & 2) && MK_ON(4)) run_gemm(lds, p.XN, p.W3, INW, DM, pg8::EpiBf16{p.Z, INW});
    MK_SYNC(4);
    if ((MK_MASK & 16) && MK_ON(5)) { MK_WL;
        scan_phase<false>(p, (LAS float*)lds, wave, lane);
        pool_phase(p, (LAS float*)lds, wave, lane); }
    MK_SYNC(5);
    if ((MK_MASK & 32) && MK_ON(6)) phase_carries(p);
    MK_SYNC(6);
    if ((MK_MASK & 64) && MK_ON(7)) { MK_WL; scan_phase<true>(p, (LAS float*)lds, wave, lane); }
    MK_SYNC(7);
    if ((MK_MASK & 2) && MK_ON(8)) run_gemm(lds, p.XN, p.W4, DM, DM, pg8::EpiBf16{p.O, DM});
    MK_SYNC(8);
    if ((MK_MASK & 8) && MK_ON(9)) { MK_WL; phase_rows<1>(p, wave, lane); }
    MK_SYNC(9);
    if ((MK_MASK & 1) && MK_ON(10)) run_gemm(lds, p.XN, p.W5, 2 * DFF, DM, pg8::EpiSwiGLU{p.H});
    MK_SYNC(10);
    if ((MK_MASK & 2) && MK_ON(11)) run_gemm(lds, p.H, p.W6, DM, DFF, pg8::EpiBf16{p.XN, DM});
    MK_SYNC(11);
    if ((MK_MASK & 8) && MK_ON(12)) { MK_WL; phase_rows<2>(p, wave, lane); }
}

extern "C" void kernel_launch(void* const* d_in, const int* in_sizes, int n_in, void* d_out, int out_size, void* d_ws, size_t ws_size, hipStream_t stream) {
    static int grid = 0;
    if (grid == 0) {
        if (n_in != 25 || out_size != T_ROWS * DM || ws_size < WS_TOTAL) { fprintf(stderr, "kernel_launch: unexpected shapes (n_in %d out %d ws %zu need %zu)\n", n_in, out_size, ws_size, (size_t)WS_TOTAL); grid = -1; return; }
        int dev = 0, cus = 0, per_cu = 0;
        hipGetDevice(&dev); hipDeviceGetAttribute(&cus, hipDeviceAttributeMultiprocessorCount, dev);
        hipFuncSetAttribute((const void*)mk_fwd<true>, hipFuncAttributeMaxDynamicSharedMemorySize, LDS_TOTAL);
        hipFuncSetAttribute((const void*)mk_fwd<false>, hipFuncAttributeMaxDynamicSharedMemorySize, LDS_TOTAL);
        hipOccupancyMaxActiveBlocksPerMultiprocessor(&per_cu, (const void*)mk_fwd<true>, 512, LDS_TOTAL);
        if (per_cu < 1) per_cu = 1;
        grid = cus * per_cu;
        (void)hipGetLastError();
    }
    if (grid < 0) return;
    Params p{};
    const float* const* in = (const float* const*)d_in;
    p.xp = in[0]; p.xs = in[1]; p.f1_pre = in[2]; p.f1_post = in[3]; p.f1_win = in[4]; p.f1_wout = in[5];
    p.mx_pre = in[6]; p.mx_post = in[7]; p.w_in = in[8]; p.conv_w = in[9]; p.conv_b = in[10]; p.w_a = in[11]; p.b_a = in[12]; p.w_x = in[13]; p.b_x = in[14];
    p.lam = in[15]; p.lru_g = in[16]; p.pool_w = in[17]; p.pool_scale = in[18]; p.pool_g = in[19]; p.w_out = in[20];
    p.f2_pre = in[21]; p.f2_post = in[22]; p.f2_win = in[23]; p.f2_wout = in[24];
    p.out = (float*)d_out;
    unsigned char* ws = (unsigned char*)d_ws;
    p.W1 = (bf16_t*)(ws + WS_W1); p.W2 = (bf16_t*)(ws + WS_W2); p.W3 = (bf16_t*)(ws + WS_W3); p.W4 = (bf16_t*)(ws + WS_W4); p.W5 = (bf16_t*)(ws + WS_W5); p.W6 = (bf16_t*)(ws + WS_W6);
    p.WG = (bf16_t*)(ws + WS_WG); p.WP = (bf16_t*)(ws + WS_WP); p.XN = (bf16_t*)(ws + WS_XN); p.XR = (bf16_t*)(ws + WS_XR); p.O = (bf16_t*)(ws + WS_H); p.H = (bf16_t*)(ws + WS_H); p.Z = (bf16_t*)(ws + WS_Z);
    p.AGG = (f32x2*)(ws + WS_AGG); p.CAR = (float*)(ws + WS_CAR); p.C8 = (float*)(ws + WS_C8); p.BAR = (unsigned*)(ws + WS_BAR); p.XA = (u32x4*)(ws + WS_XA);
#if MK_COOP
    (void)hipMemsetAsync(ws + WS_BAR, 0, XCD_BAR_WORDS * 4, stream);
    int lo = 0, hi = N_PHASES;
    void* args[] = {&p, &lo, &hi};
    hipError_t e = hipLaunchCooperativeKernel((const void*)mk_fwd<true>, dim3(grid), dim3(512), args, LDS_TOTAL, stream);
    if (e != hipSuccess) fprintf(stderr, "cooperative launch failed: %s (grid %d)\n", hipGetErrorString(e), grid);
#else
    for (int ph = 0; ph < N_PHASES; ++ph) hipLaunchKernelGGL(mk_fwd<false>, dim3(grid), dim3(512), LDS_TOTAL, stream, p, ph, ph + 1);
#endif
}
```
